# Optimizing an MI355X kernel written in HIP

```python
import math
import jax, jax.numpy as jnp
from jax import lax
import numpy as np

D_MODEL = 2048
BATCH = 2
SEQ = 4096
DEPTH = 1

HEAD_DIM = 64
N_HEADS_DIL = 12
DIL_PATTERNS = ((128, 1), (512, 4), (2048, 16))
DIL_BLOCK = 128
N_HEADS_GLA = 4
GLA_DK = 128
GLA_DV = 256
GLA_GATE_RANK = 16
GLA_TAU = 16.0
GLA_CHUNK = 64
N_HEADS_MEM = 4
MEM_LEN = 256
REL_BUCKETS = 32
REL_MAX_DIST = 2048
EPS = 1e-6
NEG_INF = -1e30

D_DIL = N_HEADS_DIL * HEAD_DIM
D_GLA_K = N_HEADS_GLA * GLA_DK
D_GLA_V = N_HEADS_GLA * GLA_DV
D_MEM = N_HEADS_MEM * HEAD_DIM
D_MIX = D_DIL + D_GLA_V + D_MEM
IN_SIZES = (D_DIL, D_DIL, D_DIL,
            D_GLA_K, D_GLA_K, D_GLA_V,
            GLA_GATE_RANK,
            D_MEM,
            D_MIX)
D_IN_PROJ = sum(IN_SIZES)
IN_SPLIT_IDX = tuple(int(i) for i in np.cumsum(IN_SIZES)[:-1])

kernel_name = "hybrid_dilated_gla_memory_block"


def rmsnorm(x, w):
    xf = x.astype(jnp.float32)
    y = xf * lax.rsqrt(jnp.mean(xf * xf, axis=-1, keepdims=True) + EPS)
    return (y * w.astype(jnp.float32)).astype(x.dtype)


def t5_bucket(dist):
    max_exact = REL_BUCKETS // 2
    n = jnp.maximum(dist, 1).astype(jnp.float32)
    large = max_exact + (jnp.log(n / max_exact) / math.log(REL_MAX_DIST / max_exact)
                         * (REL_BUCKETS - max_exact)).astype(jnp.int32)
    large = jnp.minimum(large, REL_BUCKETS - 1)
    return jnp.where(dist < max_exact, dist, large)


def dilated_attention(q, k, v, rel_bias):
    B, S, H, Dh = q.shape
    BLK = DIL_BLOCK
    i = jnp.arange(BLK)[:, None]
    m = jnp.arange(2 * BLK)[None, :]
    rel = i - m + BLK
    outs, lses = [], []
    for window, dil in DIL_PATTERNS:
        back = window // dil
        assert back <= BLK
        L = S // dil
        nb = -(-L // BLK)
        Lp = nb * BLK

        def to_sub(t):
            return t.reshape(B, L, dil, H, Dh).transpose(0, 2, 3, 1, 4)

        qs, ks, vs = to_sub(q), to_sub(k), to_sub(v)
        qb = jnp.pad(qs, ((0, 0),) * 3 + ((0, Lp - L), (0, 0))).reshape(B, dil, H, nb, BLK, Dh)

        def band(t):
            tp = jnp.pad(t, ((0, 0),) * 3 + ((BLK, Lp - L), (0, 0)))
            prev = tp[..., :Lp, :].reshape(B, dil, H, nb, BLK, Dh)
            cur = tp[..., BLK:, :].reshape(B, dil, H, nb, BLK, Dh)
            return jnp.concatenate([prev, cur], axis=-2)

        kb, vb = band(ks), band(vs)
        key_idx = jnp.arange(nb)[:, None, None] * BLK - BLK + m[None]
        mask = (rel >= 0)[None] & (rel <= back)[None] & (key_idx >= 0)
        bias = rel_bias.astype(jnp.float32)[t5_bucket(jnp.clip(rel, 0, back) * dil)]
        bias = bias.transpose(2, 0, 1)
        logits = jnp.einsum('bghnqc,bghnkc->bghnqk', qb.astype(jnp.float32), kb.astype(jnp.float32))
        logits = logits + bias[None, None, :, None]
        logits = jnp.where(mask[None, None, None], logits, NEG_INF)
        mx = jnp.max(logits, axis=-1, keepdims=True)
        p = jnp.exp(logits - mx)
        den = jnp.sum(p, axis=-1, keepdims=True)
        o = jnp.einsum('bghnqk,bghnkc->bghnqc', p, vb.astype(jnp.float32)) / den
        lse = (mx + jnp.log(den))[..., 0]
        o = o.reshape(B, dil, H, Lp, Dh)[..., :L, :].transpose(0, 3, 1, 2, 4).reshape(B, S, H, Dh)
        lse = lse.reshape(B, dil, H, Lp)[..., :L].transpose(0, 3, 1, 2).reshape(B, S, H)
        outs.append(o)
        lses.append(lse)
    w = jax.nn.softmax(jnp.stack(lses, axis=0), axis=0)
    out = jnp.sum(w[..., None] * jnp.stack(outs, axis=0), axis=0)
    return out.astype(q.dtype)


def gla_attention(q, k, v, log_alpha, norm_w):
    B, S, H, dk = q.shape
    dv = v.shape[-1]
    C = GLA_CHUNK
    N = S // C
    f32 = lambda t: t.astype(jnp.float32).reshape(B, N, C, H, t.shape[-1])
    qc, kc, vc, la = f32(q), f32(k), f32(v), f32(log_alpha)
    b = jnp.cumsum(la, axis=2)
    b_last = b[:, :, -1:]
    q_t = qc * jnp.exp(b)
    k_t = kc * jnp.exp(-b)
    k_s = kc * jnp.exp(b_last - b)
    causal = jnp.tril(jnp.ones((C, C), dtype=bool))
    A = jnp.einsum('bnqhc,bnkhc->bnhqk', q_t, k_t)
    A = jnp.where(causal, A, 0.0)
    o_intra = jnp.einsum('bnhqk,bnkhv->bnqhv', A, vc)
    kv = jnp.einsum('bnkhc,bnkhv->bnhcv', k_s, vc)
    decay = jnp.exp(b_last[:, :, 0])

    def step(state, inp):
        dec, kv_n = inp
        return dec[..., None] * state + kv_n, state

    _, states = lax.scan(step, jnp.zeros((B, H, dk, dv), jnp.float32),
                         (jnp.moveaxis(decay, 1, 0), jnp.moveaxis(kv, 1, 0)))
    states = jnp.moveaxis(states, 0, 1)
    o_inter = jnp.einsum('bnqhc,bnhcv->bnqhv', q_t, states)
    o = (o_intra + o_inter).reshape(B, S, H, dv)
    return rmsnorm(o, norm_w).astype(q.dtype)


def memory_attention(q, mem_n, w_mem_kv):
    B, M, _ = mem_n.shape
    kv = mem_n @ w_mem_kv
    mk, mv = jnp.split(kv, 2, axis=-1)
    mk = mk.reshape(B, M, N_HEADS_MEM, HEAD_DIM)
    mv = mv.reshape(B, M, N_HEADS_MEM, HEAD_DIM)
    logits = jnp.einsum('bshc,bmhc->bhsm', q.astype(jnp.float32), mk.astype(jnp.float32))
    p = jax.nn.softmax(logits, axis=-1)
    return jnp.einsum('bhsm,bmhc->bshc', p, mv.astype(jnp.float32)).astype(q.dtype)


def setup_inputs(seed: int = 0) -> dict:
    key = jax.random.key(seed)
    ks = jax.random.split(key, 12)
    nrm = lambda k, shape, s: jax.random.normal(k, shape, jnp.float32) * s
    return {
        "x": nrm(ks[0], (BATCH, SEQ, D_MODEL), 1.0),
        "mem": nrm(ks[1], (BATCH, MEM_LEN, D_MODEL), 1.0),
        "norm_pre_w": 1.0 + nrm(ks[2], (DEPTH, D_MODEL), 0.02),
        "w_in": nrm(ks[3], (DEPTH, D_MODEL, D_IN_PROJ), D_MODEL ** -0.5),
        "rel_bias": nrm(ks[4], (REL_BUCKETS, N_HEADS_DIL), 0.1),
        "w_gla_gate2": nrm(ks[5], (DEPTH, GLA_GATE_RANK, D_GLA_K), GLA_GATE_RANK ** -0.5),
        "b_gla_gate": nrm(ks[6], (DEPTH, D_GLA_K), 0.1),
        "gla_norm_w": 1.0 + nrm(ks[7], (DEPTH, GLA_DV), 0.02),
        "mem_norm_w": 1.0 + nrm(ks[8], (DEPTH, D_MODEL), 0.02),
        "w_mem_kv": nrm(ks[9], (DEPTH, D_MODEL, 2 * D_MEM), D_MODEL ** -0.5),
        "w_out": nrm(ks[10], (DEPTH, D_MIX, D_MODEL), D_MIX ** -0.5),
        "norm_post_w": 1.0 + nrm(ks[11], (DEPTH, D_MODEL), 0.02),
    }


def reference(x, mem, norm_pre_w, w_in, rel_bias, w_gla_gate2, b_gla_gate, gla_norm_w,
              mem_norm_w, w_mem_kv, w_out, norm_post_w):
    B, S, _ = x.shape
    for l in range(DEPTH):
        h = rmsnorm(x, norm_pre_w[l])
        proj = h @ w_in[l]
        dq, dk, dv, gq, gk, gv, g_lr, mq, gate = jnp.split(proj, IN_SPLIT_IDX, axis=-1)
        a = dilated_attention(dq.reshape(B, S, N_HEADS_DIL, HEAD_DIM) * (HEAD_DIM ** -0.5),
                              dk.reshape(B, S, N_HEADS_DIL, HEAD_DIM),
                              dv.reshape(B, S, N_HEADS_DIL, HEAD_DIM), rel_bias)
        log_alpha = jax.nn.log_sigmoid((g_lr @ w_gla_gate2[l] + b_gla_gate[l]).astype(jnp.float32)) / GLA_TAU
        o_gla = gla_attention(gq.reshape(B, S, N_HEADS_GLA, GLA_DK) * (GLA_DK ** -0.5),
                              gk.reshape(B, S, N_HEADS_GLA, GLA_DK),
                              gv.reshape(B, S, N_HEADS_GLA, GLA_DV),
                              log_alpha.reshape(B, S, N_HEADS_GLA, GLA_DK), gla_norm_w[l])
        o_mem = memory_attention(mq.reshape(B, S, N_HEADS_MEM, HEAD_DIM) * (HEAD_DIM ** -0.5),
                                 rmsnorm(mem, mem_norm_w[l]), w_mem_kv[l])
        mix = jnp.concatenate([a.reshape(B, S, D_DIL), o_gla.reshape(B, S, D_GLA_V),
                               o_mem.reshape(B, S, D_MEM)], axis=-1)
        y = (mix * jax.nn.silu(gate)) @ w_out[l]
        x = x + rmsnorm(y, norm_post_w[l])
    return x
```

```cpp
#include <hip/hip_runtime.h>
#include <cstdint>
#include <cstdio>
#include <cmath>

constexpr int BATCH = 2, SEQ = 4096, DM = 2048, M = BATCH * SEQ;
constexpr int NH_DIL = 12, HD = 64, D_DIL = 768;
constexpr int NH_GLA = 4, GDK = 128, GDV = 256, GRANK = 16, D_GK = 512, D_GV = 1024;
constexpr int NH_MEM = 4, MEML = 256, D_MEM = 256;
constexpr int D_MIX = 2048, NPROJ = 6672;
constexpr int C_DQ = 0, C_DK = 768, C_DV = 1536, C_GQ = 2304, C_GK = 2816, C_GV = 3328, C_LR = 4352, C_MQ = 4368, C_GATE = 4624;
constexpr float EPS = 1e-6f;

typedef unsigned short bf16_t;
__device__ __forceinline__ unsigned f2bf(float f) { unsigned u = __builtin_bit_cast(unsigned, f); return (u + 0x7fffu + ((u >> 16) & 1u)) >> 16; }
__device__ __forceinline__ float bf2f(unsigned short h) { return __builtin_bit_cast(float, ((unsigned)h) << 16); }
__device__ __forceinline__ float bfround(float f) { return bf2f((unsigned short)f2bf(f)); }

constexpr size_t MiB = 1u << 20;
constexpr size_t WS_CTL = 0;
constexpr size_t WS_RSTDX = 1 * MiB, WS_RSTDM = 1 * MiB + 64 * 1024, WS_BIAS = 1 * MiB + 128 * 1024, WS_DEC = 1 * MiB + 512 * 1024;
constexpr size_t WS_GLR = 2 * MiB, WS_MK = 2 * MiB + 512 * 1024, WS_MV = 2 * MiB + 768 * 1024, WS_LSE = 3 * MiB, WS_MEMB = 5 * MiB;
constexpr size_t WS_WOUT = 8 * MiB, WS_WMEM = 16 * MiB, WS_WIN = 18 * MiB, WS_XB = 45 * MiB;
constexpr size_t WS_DQ = 77 * MiB, WS_DK = 89 * MiB, WS_DV = 101 * MiB, WS_OP = 113 * MiB;
constexpr size_t WS_GQ = 149 * MiB, WS_GK = 157 * MiB, WS_GV = 165 * MiB, WS_MQ = 181 * MiB, WS_SG = 185 * MiB, WS_MIXG = 217 * MiB;
constexpr size_t WS_KV = 18 * MiB, WS_SN = 50 * MiB, WS_Y = 82 * MiB;

__global__ void k_prep_rows(const float* __restrict__ x, bf16_t* __restrict__ xb, float* __restrict__ rstd, int nrows) {
    const int wave = (blockIdx.x * blockDim.x + threadIdx.x) >> 6, lane = threadIdx.x & 63;
    if (wave >= nrows) return;
    const float* xr = x + (size_t)wave * DM;
    float s = 0.f;
    for (int i = lane; i < DM; i += 64) { float v = xr[i]; s += v * v; xb[(size_t)wave * DM + i] = (bf16_t)f2bf(v); }
    for (int o = 32; o > 0; o >>= 1) s += __shfl_xor(s, o);
    if (lane == 0) rstd[wave] = 1.0f / sqrtf(s / DM + EPS);
}

__global__ void __launch_bounds__(256) k_gemm_naive(const bf16_t* __restrict__ A, const float* __restrict__ B, const float* __restrict__ kw,
                                                    const float* __restrict__ rs, int Mr, int N, int K, int mode, unsigned char* ws) {
    __shared__ float As[16][64 + 1];
    __shared__ float Bs[16][64 + 1];
    const int tx = threadIdx.x & 15, ty = threadIdx.x >> 4;
    const int m0 = blockIdx.y * 64, n0 = blockIdx.x * 64;
    float acc[4][4] = {};
    for (int k0 = 0; k0 < K; k0 += 16) {
        for (int i = threadIdx.x; i < 64 * 16; i += 256) {
            const int r = i >> 4, kk = i & 15;
            As[kk][r] = bf2f(A[(size_t)(m0 + r) * K + k0 + kk]);
        }
        for (int i = threadIdx.x; i < 64 * 16; i += 256) {
            const int kk = i >> 6, c = i & 63;
            const int n = n0 + c;
            float v = 0.f;
            if (n < N) { v = B[(size_t)(k0 + kk) * N + n]; if (kw) v *= kw[k0 + kk]; v = bfround(v); }
            Bs[kk][c] = v;
        }
        __syncthreads();
#pragma unroll
        for (int kk = 0; kk < 16; ++kk) {
            float a[4], b[4];
#pragma unroll
            for (int i = 0; i < 4; ++i) { a[i] = As[kk][ty * 4 + i]; b[i] = Bs[kk][tx * 4 + i]; }
#pragma unroll
            for (int i = 0; i < 4; ++i)
#pragma unroll
                for (int j = 0; j < 4; ++j) acc[i][j] += a[i] * b[j];
        }
        __syncthreads();
    }
    for (int i = 0; i < 4; ++i) {
        const int m = m0 + ty * 4 + i;
        const float r = rs ? rs[m] : 1.f;
        for (int j = 0; j < 4; ++j) {
            const int n = n0 + tx * 4 + j;
            if (n >= N) continue;
            const float v = acc[i][j] * r;
            if (mode == 0) {
                if (n < C_DK) ((bf16_t*)(ws + WS_DQ))[(size_t)m * 768 + n] = (bf16_t)f2bf(v * 0.125f);
                else if (n < C_DV) ((bf16_t*)(ws + WS_DK))[(size_t)m * 768 + (n - C_DK)] = (bf16_t)f2bf(v);
                else if (n < C_GQ) ((bf16_t*)(ws + WS_DV))[(size_t)m * 768 + (n - C_DV)] = (bf16_t)f2bf(v);
                else if (n < C_GK) ((bf16_t*)(ws + WS_GQ))[(size_t)m * 512 + (n - C_GQ)] = (bf16_t)f2bf(v * 0.08838834764831845f);
                else if (n < C_GV) ((bf16_t*)(ws + WS_GK))[(size_t)m * 512 + (n - C_GK)] = (bf16_t)f2bf(v);
                else if (n < C_LR) ((bf16_t*)(ws + WS_GV))[(size_t)m * 1024 + (n - C_GV)] = (bf16_t)f2bf(v);
                else if (n < C_MQ) ((float*)(ws + WS_GLR))[(size_t)m * 16 + (n - C_LR)] = v;
                else if (n < C_GATE) ((bf16_t*)(ws + WS_MQ))[(size_t)m * 256 + (n - C_MQ)] = (bf16_t)f2bf(v * 0.125f);
                else ((bf16_t*)(ws + WS_SG))[(size_t)m * 2048 + (n - C_GATE)] = (bf16_t)f2bf(v / (1.f + __expf(-v)));
            } else if (mode == 1) {
                if (n < 256) ((bf16_t*)(ws + WS_MK))[(size_t)m * 256 + n] = (bf16_t)f2bf(v);
                else ((bf16_t*)(ws + WS_MV))[(size_t)m * 256 + (n - 256)] = (bf16_t)f2bf(v);
            } else {
                ((float*)(ws + WS_Y))[(size_t)m * N + n] = v;
            }
        }
    }
}

__device__ __forceinline__ int t5_bucket(int dist) {
    if (dist < 16) return dist;
    const double v = log((double)dist / 16.0) / log(128.0) * 16.0;
    int large = 16 + (int)v;
    return large < 31 ? large : 31;
}

__global__ void k_bias_table(const float* __restrict__ rel_bias, float* __restrict__ T) {
    const int i = blockIdx.x * blockDim.x + threadIdx.x;
    if (i >= 3 * 12 * 132) return;
    const int rel = i % 132, h = (i / 132) % 12, p = i / (132 * 12);
    const int dil = p == 0 ? 1 : (p == 1 ? 4 : 16);
    float v = 0.f;
    if (rel <= 128) v = rel_bias[t5_bucket(rel * dil) * 12 + h];
    T[i] = v;
}

__global__ void __launch_bounds__(256) k_dil_attn_naive(const bf16_t* __restrict__ DQ, const bf16_t* __restrict__ DK, const bf16_t* __restrict__ DV, const float* __restrict__ T,
                                 bf16_t* __restrict__ OP, float* __restrict__ LSE) {
    const int i = blockIdx.x * blockDim.x + threadIdx.x;
    if (i >= M * 12 * 3) return;
    const int h = i % 12, m = (i / 12) % M, p = i / (12 * M);
    const int b = m / SEQ, t = m % SEQ;
    const int dil = p == 0 ? 1 : (p == 1 ? 4 : 16);
    float q[64];
    for (int d = 0; d < 64; ++d) q[d] = bf2f(DQ[(size_t)m * 768 + h * 64 + d]);
    float mx = -1e30f, l = 0.f, o[64];
    for (int d = 0; d < 64; ++d) o[d] = 0.f;
    for (int rel = 0; rel <= 128; ++rel) {
        const int tk = t - rel * dil;
        if (tk < 0) break;
        const size_t km = (size_t)(b * SEQ + tk);
        float s = 0.f;
        for (int d = 0; d < 64; ++d) s += q[d] * bf2f(DK[km * 768 + h * 64 + d]);
        s += T[(p * 12 + h) * 132 + rel];
        const float mn = fmaxf(mx, s), a = __expf(mx - mn), pe = __expf(s - mn);
        l = l * a + pe;
        for (int d = 0; d < 64; ++d) o[d] = o[d] * a + pe * bf2f(DV[km * 768 + h * 64 + d]);
        mx = mn;
    }
    const float inv = 1.f / l;
    for (int d = 0; d < 64; ++d) OP[(size_t)p * M * 768 + (size_t)m * 768 + h * 64 + d] = (bf16_t)f2bf(o[d] * inv);
    LSE[((size_t)p * M + m) * 12 + h] = mx + __logf(l);
}

__global__ void k_dil_combine(const bf16_t* __restrict__ OP, const float* __restrict__ LSE, const bf16_t* __restrict__ SG, bf16_t* __restrict__ MIXG) {
    const int i = blockIdx.x * blockDim.x + threadIdx.x;
    if (i >= M * 768) return;
    const int c = i % 768, m = i / 768, h = c / 64;
    float l0 = LSE[((size_t)0 * M + m) * 12 + h], l1 = LSE[((size_t)1 * M + m) * 12 + h], l2 = LSE[((size_t)2 * M + m) * 12 + h];
    const float mx = fmaxf(l0, fmaxf(l1, l2));
    const float w0 = __expf(l0 - mx), w1 = __expf(l1 - mx), w2 = __expf(l2 - mx);
    const float o = (w0 * bf2f(OP[(size_t)m * 768 + c]) + w1 * bf2f(OP[(size_t)M * 768 + (size_t)m * 768 + c]) + w2 * bf2f(OP[(size_t)2 * M * 768 + (size_t)m * 768 + c])) / (w0 + w1 + w2);
    MIXG[(size_t)m * 2048 + c] = (bf16_t)f2bf(o * bf2f(SG[(size_t)m * 2048 + c]));
}

__global__ void __launch_bounds__(256) k_mem_attn_naive(const bf16_t* __restrict__ MQ, const bf16_t* __restrict__ MK, const bf16_t* __restrict__ MV, const bf16_t* __restrict__ SG, bf16_t* __restrict__ MIXG) {
    const int i = blockIdx.x * blockDim.x + threadIdx.x;
    if (i >= M * 4) return;
    const int h = i % 4, m = i / 4, b = m / SEQ;
    float q[64];
    for (int d = 0; d < 64; ++d) q[d] = bf2f(MQ[(size_t)m * 256 + h * 64 + d]);
    float mx = -1e30f, l = 0.f, o[64];
    for (int d = 0; d < 64; ++d) o[d] = 0.f;
    for (int j = 0; j < MEML; ++j) {
        const size_t km = (size_t)(b * MEML + j);
        float s = 0.f;
        for (int d = 0; d < 64; ++d) s += q[d] * bf2f(MK[km * 256 + h * 64 + d]);
        const float mn = fmaxf(mx, s), a = __expf(mx - mn), pe = __expf(s - mn);
        l = l * a + pe;
        for (int d = 0; d < 64; ++d) o[d] = o[d] * a + pe * bf2f(MV[km * 256 + h * 64 + d]);
        mx = mn;
    }
    const float inv = 1.f / l;
    for (int d = 0; d < 64; ++d) { const int c = 1792 + h * 64 + d; MIXG[(size_t)m * 2048 + c] = (bf16_t)f2bf(o[d] * inv * bf2f(SG[(size_t)m * 2048 + c])); }
}

__global__ void __launch_bounds__(256) k_gla_naive(const bf16_t* __restrict__ GQ, const bf16_t* __restrict__ GK, const bf16_t* __restrict__ GV, const float* __restrict__ GLR,
                                                   const float* __restrict__ w2, const float* __restrict__ bg, const float* __restrict__ gnw, const bf16_t* __restrict__ SG, bf16_t* __restrict__ MIXG) {
    __shared__ float sq[128], sk[128], sa[128], red[4];
    const int b = blockIdx.x / 4, h = blockIdx.x % 4, v = threadIdx.x;
    float S[128];
#pragma unroll
    for (int c = 0; c < 128; ++c) S[c] = 0.f;
    float wcol[16]; float bgc = 0.f;
    if (v < 128) { for (int j = 0; j < 16; ++j) wcol[j] = w2[j * 512 + h * 128 + v]; bgc = bg[h * 128 + v]; }
    const float gw = gnw[v];
    for (int t = 0; t < SEQ; ++t) {
        const size_t m = (size_t)b * SEQ + t;
        if (v < 128) {
            float z = bgc;
            for (int j = 0; j < 16; ++j) z += GLR[m * 16 + j] * wcol[j];
            const float ls = fminf(z, 0.f) - log1pf(__expf(-fabsf(z)));
            sa[v] = __expf(ls * (1.f / 16.f));
            sq[v] = bf2f(GQ[m * 512 + h * 128 + v]);
            sk[v] = bf2f(GK[m * 512 + h * 128 + v]);
        }
        __syncthreads();
        const float vv = bf2f(GV[m * 1024 + h * 256 + v]);
        float o = 0.f;
#pragma unroll
        for (int c = 0; c < 128; ++c) { S[c] = sa[c] * S[c] + sk[c] * vv; o += sq[c] * S[c]; }
        float s2 = o * o;
        for (int of = 32; of > 0; of >>= 1) s2 += __shfl_xor(s2, of);
        if ((v & 63) == 0) red[v >> 6] = s2;
        __syncthreads();
        const float tot = red[0] + red[1] + red[2] + red[3];
        const float r = 1.f / sqrtf(tot / 256.f + EPS);
        const int c = 768 + h * 256 + v;
        MIXG[m * 2048 + c] = (bf16_t)f2bf(o * r * gw * bf2f(SG[m * 2048 + c]));
    }
}

__global__ void k_final(const float* __restrict__ x, const float* __restrict__ Y, const float* __restrict__ w, float* __restrict__ out) {
    const int wave = (blockIdx.x * blockDim.x + threadIdx.x) >> 6, lane = threadIdx.x & 63;
    if (wave >= M) return;
    const float* yr = Y + (size_t)wave * DM;
    float s = 0.f;
    for (int i = lane; i < DM; i += 64) { float v = yr[i]; s += v * v; }
    for (int o = 32; o > 0; o >>= 1) s += __shfl_xor(s, o);
    const float r = 1.0f / sqrtf(s / DM + EPS);
    for (int i = lane; i < DM; i += 64) out[(size_t)wave * DM + i] = x[(size_t)wave * DM + i] + yr[i] * r * w[i];
}

namespace pg8 {
#define PG8_LAS __attribute__((address_space(3)))
typedef unsigned short bf16_t;
typedef short bf16x8 __attribute__((ext_vector_type(8)));
typedef float f32x4 __attribute__((ext_vector_type(4)));
typedef unsigned u32x4 __attribute__((ext_vector_type(4)));
constexpr int BM = 256, BK = 64, HALF = 128, HTB = HALF * BK * 2  , STAGE_BYTES = 8 * HTB, NXCD = 8, WGM = 8;

__host__ __device__ __forceinline__ int lds_byte(int r, int c) { const int st = (r >> 4) * 2 + (c >> 5), rr = r & 15, cc = c & 31, ob = rr * 64 + cc * 2; return st * 1024 + (ob ^ (((ob >> 9) & 1) << 5)); }
__host__ __device__ __forceinline__ void stage_rc(int b, int& R, int& C) { const int st = b / 1024, sb = b % 1024, swz = sb ^ (((sb >> 9) & 1) << 5); R = (st >> 1) * 16 + swz / 64; C = (st & 1) * 32 + (swz % 64) / 2; }
__host__ __device__ __forceinline__ int perm32(int rho) { const int n = rho >> 4, i = rho & 15; return 8 * (i >> 2) + 4 * n + (i & 3); }

struct Unit { int pm, pn; };
struct Gemm { const bf16_t* A; const bf16_t* Bt; int M, N, K; };

struct StaticOrder {
    int nM, nN, nwg, G, c;
    __host__ __device__ void init(int M, int N, int G_, int c_) { nM = M / BM; nN = N / BM; nwg = nM * nN; G = G_; c = c_; }
    __host__ __device__ bool next(int i, Unit& u) const {
        const long L = (long)i * G + c; if (L >= nwg) return false;
        int wgid = (int)L; { const int q = nwg / NXCD, r = nwg % NXCD, xcd = wgid % NXCD, off = wgid / NXCD; wgid = (xcd < r ? xcd * (q + 1) : r * (q + 1) + (xcd - r) * q) + off; }
        const int nig = WGM * nN, gid = wgid / nig, fm = gid * WGM, gsz = (nM - fm) < WGM ? (nM - fm) : WGM;
        u.pm = fm + ((wgid % nig) % gsz); u.pn = (wgid % nig) / gsz; return true;
    }
    __device__ __forceinline__ void a_ready(const Unit&) const {}
    __device__ __forceinline__ void done(const Unit&) const {}
};


__device__ __forceinline__ unsigned cvt_pk_bf16(float lo, float hi) { unsigned r; asm volatile("v_cvt_pk_bf16_f32 %0, %1, %2" : "=v"(r) : "v"(lo), "v"(hi)); return r; }

struct EpiProj {
    static constexpr bool PERM = true, AFTER_DRAIN = false;
    unsigned char* ws; const float* rstd;
    __device__ __forceinline__ void operator()(const f32x4 (&acc)[2][2][4][2], const Unit& u, int wr, int wc, int fr, int fq) const {
        const int row0 = u.pm * BM + wr * 64 + fr; const int t = u.pn;
        bf16_t* base; int ldc, coff; float sc = 1.f; int act = 0;
        if (t < 3)       { base = (bf16_t*)(ws + WS_DQ); ldc = 768;  coff = t * 256;        sc = 0.125f; }
        else if (t < 6)  { base = (bf16_t*)(ws + WS_DK); ldc = 768;  coff = (t - 3) * 256; }
        else if (t < 9)  { base = (bf16_t*)(ws + WS_DV); ldc = 768;  coff = (t - 6) * 256; }
        else if (t < 11) { base = (bf16_t*)(ws + WS_GQ); ldc = 512;  coff = (t - 9) * 256;  sc = 0.08838834764831845f; }
        else if (t < 13) { base = (bf16_t*)(ws + WS_GK); ldc = 512;  coff = (t - 11) * 256; }
        else if (t < 17) { base = (bf16_t*)(ws + WS_GV); ldc = 1024; coff = (t - 13) * 256; }
        else if (t == 17){ base = (bf16_t*)(ws + WS_MQ); ldc = 256;  coff = 0;              sc = 0.125f; }
        else if (t < 26) { base = (bf16_t*)(ws + WS_SG); ldc = 2048; coff = (t - 18) * 256; act = 1; }
        else             { base = nullptr; ldc = 16; coff = 0; act = 2; }
        if (act == 2) {
            if (wc == 0 && fq < 2) {
                float* G = (float*)(ws + WS_GLR);
#pragma unroll
                for (int ai = 0; ai < 2; ++ai)
#pragma unroll
                    for (int m = 0; m < 4; ++m) { const int r = row0 + ai * HALF + m * 16; const float rs = rstd[r];
                        *(f32x4*)(G + (size_t)r * 16 + 8 * fq) = acc[ai][0][m][0] * rs; *(f32x4*)(G + (size_t)r * 16 + 8 * fq + 4) = acc[ai][0][m][1] * rs; }
            }
            return;
        }
        const int col0 = coff + wc * 32 + 8 * fq;
#pragma unroll
        for (int ai = 0; ai < 2; ++ai)
#pragma unroll
            for (int m = 0; m < 4; ++m) { const int r = row0 + ai * HALF + m * 16; const float rs = rstd[r] * sc; bf16_t* rowp = base + (size_t)r * ldc + col0;
#pragma unroll
                for (int bj = 0; bj < 2; ++bj) { f32x4 v0 = acc[ai][bj][m][0] * rs, v1 = acc[ai][bj][m][1] * rs;
                    if (act == 1) {
#pragma unroll
                        for (int i = 0; i < 4; ++i) { v0[i] = v0[i] * __builtin_amdgcn_rcpf(1.f + __expf(-v0[i])); v1[i] = v1[i] * __builtin_amdgcn_rcpf(1.f + __expf(-v1[i])); }
                    }
                    u32x4 w; w.x = cvt_pk_bf16(v0[0], v0[1]); w.y = cvt_pk_bf16(v0[2], v0[3]); w.z = cvt_pk_bf16(v1[0], v1[1]); w.w = cvt_pk_bf16(v1[2], v1[3]);
                    *(u32x4*)(rowp + bj * HALF) = w; } }
    }
};
struct EpiMemKV {
    static constexpr bool PERM = true, AFTER_DRAIN = false;
    unsigned char* ws; const float* rstd;
    __device__ __forceinline__ void operator()(const f32x4 (&acc)[2][2][4][2], const Unit& u, int wr, int wc, int fr, int fq) const {
        const int row0 = u.pm * BM + wr * 64 + fr;
        bf16_t* base = (bf16_t*)(ws + (u.pn == 0 ? WS_MK : WS_MV));
        const int col0 = wc * 32 + 8 * fq;
#pragma unroll
        for (int ai = 0; ai < 2; ++ai)
#pragma unroll
            for (int m = 0; m < 4; ++m) { const int r = row0 + ai * HALF + m * 16; const float rs = rstd[r]; bf16_t* rowp = base + (size_t)r * 256 + col0;
#pragma unroll
                for (int bj = 0; bj < 2; ++bj) { const f32x4 v0 = acc[ai][bj][m][0] * rs, v1 = acc[ai][bj][m][1] * rs;
                    u32x4 w; w.x = cvt_pk_bf16(v0[0], v0[1]); w.y = cvt_pk_bf16(v0[2], v0[3]); w.z = cvt_pk_bf16(v1[0], v1[1]); w.w = cvt_pk_bf16(v1[2], v1[3]);
                    *(u32x4*)(rowp + bj * HALF) = w; } }
    }
};
struct EpiF32 {
    static constexpr bool PERM = false, AFTER_DRAIN = false;
    float* O; int ldc;
    __device__ __forceinline__ void operator()(const f32x4 (&acc)[2][2][4][2], const Unit& u, int wr, int wc, int fr, int fq) const {
        const int row0 = u.pm * BM + wr * 64 + fr, col0 = u.pn * BM + wc * 32 + 4 * fq;
#pragma unroll
        for (int ai = 0; ai < 2; ++ai)
#pragma unroll
            for (int m = 0; m < 4; ++m) { float* rowp = O + (size_t)(row0 + ai * HALF + m * 16) * ldc + col0;
#pragma unroll
                for (int bj = 0; bj < 2; ++bj)
#pragma unroll
                    for (int n = 0; n < 2; ++n) *(f32x4*)(rowp + bj * HALF + n * 16) = acc[ai][bj][m][n]; }
    }
};

template <class Epi, class Sched, bool ALIGN_EPI = false, bool SP2 = false>
__device__ __forceinline__ void gemm_phase(PG8_LAS unsigned char* lds, const Gemm g, const Sched& S, const Epi& E) {
    const int tid = threadIdx.x, wid = __builtin_amdgcn_readfirstlane(tid >> 6), lane = tid & 63, wr = wid >> 2, wc = wid & 3, fr = lane & 15, fq = lane >> 4;
    const int K = g.K, nt = K / BK;
    unsigned voffA[2], voffB[2];
#pragma unroll
    for (int i = 0; i < 2; ++i) { int R, C; stage_rc(tid * 16 + i * 8192, R, C); const int Rb = Epi::PERM ? ((R & ~31) + perm32(R & 31)) : R;
        voffA[i] = (unsigned)(R * K + C) * 2u; voffB[i] = (unsigned)(Rb * K + C) * 2u; }
    const size_t kstep = (size_t)(BK * 2);
    const size_t hstep = (size_t)HALF * K * 2;
    const size_t tstep = 2 * hstep;
    const unsigned ldsw = (unsigned)wid * 1024u;
    const int aoff = lds_byte(wr * 64 + fr, fq * 8), boff = lds_byte(wc * 32 + fr, fq * 8);
#define PG8_SA(b, h) (((b) * 2 + (h)) * HTB)
#define PG8_SB(b, h) ((4 + (b) * 2 + (h)) * HTB)
#define PG8_STAGE(bufoff, gbase, voff) do { _Pragma("unroll") for (int _i = 0; _i < 2; ++_i) \
        __builtin_amdgcn_global_load_lds((const unsigned*)((const char*)(gbase) + (voff)[_i]), (PG8_LAS unsigned*)(lds + (bufoff) + ldsw + _i * 8192), 16, 0, 0); } while (0)
#define PG8_LDA(dst, b, h) do { _Pragma("unroll") for (int m = 0; m < 4; ++m) _Pragma("unroll") for (int k = 0; k < 2; ++k) dst[m][k] = *(const PG8_LAS bf16x8*)(lds + PG8_SA(b, h) + aoff + m * 2048 + k * 1024); } while (0)
#define PG8_LDB(dst, b, h) do { _Pragma("unroll") for (int n = 0; n < 2; ++n) _Pragma("unroll") for (int k = 0; k < 2; ++k) dst[n][k] = *(const PG8_LAS bf16x8*)(lds + PG8_SB(b, h) + boff + n * 2048 + k * 1024); } while (0)
#define PG8_MMA(ai, bj, At, Bt) do { __builtin_amdgcn_s_setprio(1); _Pragma("unroll") for (int m = 0; m < 4; ++m) _Pragma("unroll") for (int n = 0; n < 2; ++n) _Pragma("unroll") for (int k = 0; k < 2; ++k) \
        acc[ai][bj][m][n] = __builtin_amdgcn_mfma_f32_16x16x32_bf16(Bt[n][k], At[m][k], acc[ai][bj][m][n], 0, 0, 0); __builtin_amdgcn_s_setprio(0); } while (0)
#define PG8_WAIT_V(n) asm volatile("s_waitcnt vmcnt(" #n ")" ::: "memory")
#define PG8_WAIT_L(n) asm volatile("s_waitcnt lgkmcnt(" #n ")" ::: "memory")
#define PG8_BAR __builtin_amdgcn_s_barrier()
#define PG8_SCHED __builtin_amdgcn_sched_barrier(0)
    Unit cur, nxt; int ui = 0;
    if (!S.next(0, cur)) return;
    f32x4 acc[2][2][4][2];
#pragma unroll
    for (int a = 0; a < 2; ++a)
#pragma unroll
        for (int b = 0; b < 2; ++b)
#pragma unroll
            for (int m = 0; m < 4; ++m)
#pragma unroll
                for (int n = 0; n < 2; ++n) acc[a][b][m][n] = (f32x4){0.f, 0.f, 0.f, 0.f};
    bf16x8 At[4][2], B0[2][2], B1[2][2];
    const char* cA = (const char*)g.A + (size_t)cur.pm * tstep; const char* cB = (const char*)g.Bt + (size_t)cur.pn * tstep;
    S.a_ready(cur);
    if constexpr (SP2) {
        PG8_STAGE(PG8_SB(0, 0), cB, voffB); PG8_STAGE(PG8_SB(0, 1), cB + hstep, voffB); PG8_STAGE(PG8_SA(0, 0), cA, voffA); PG8_STAGE(PG8_SA(0, 1), cA + hstep, voffA);
        if (wr == 1) PG8_BAR;
        PG8_WAIT_V(2); PG8_BAR;
        PG8_STAGE(PG8_SB(1, 0), cB + kstep, voffB); PG8_STAGE(PG8_SA(1, 0), cA + kstep, voffA); PG8_STAGE(PG8_SB(1, 1), cB + hstep + kstep, voffB);
        PG8_WAIT_V(6); PG8_BAR;
    } else {
        PG8_STAGE(PG8_SB(0, 0), cB, voffB); PG8_STAGE(PG8_SA(0, 0), cA, voffA); PG8_STAGE(PG8_SB(0, 1), cB + hstep, voffB); PG8_STAGE(PG8_SA(0, 1), cA + hstep, voffA);
        if (wr == 1) PG8_BAR;
        PG8_WAIT_V(4); PG8_BAR;
        PG8_STAGE(PG8_SB(1, 0), cB + kstep, voffB); PG8_STAGE(PG8_SA(1, 0), cA + kstep, voffA); PG8_STAGE(PG8_SB(1, 1), cB + hstep + kstep, voffB);
        PG8_WAIT_V(6); PG8_BAR;
    }
    for (;;) {
        const bool has_next = S.next(ui + 1, nxt);
        const char* nA = has_next ? (const char*)g.A + (size_t)nxt.pm * tstep : cA; const char* nB = has_next ? (const char*)g.Bt + (size_t)nxt.pn * tstep : cB;
        for (int t = 0; t < nt; t += 2) {
            const bool last = (t == nt - 2);
            const char* a1 = cA + (size_t)(t + 1) * kstep;
            const char* a2 = last ? nA : cA + (size_t)(t + 2) * kstep; const char* b2 = last ? nB : cB + (size_t)(t + 2) * kstep;
            const char* a3 = a2 + kstep; const char* b3 = b2 + kstep;
            if (last && has_next) S.a_ready(nxt);
            if constexpr (SP2) {
            PG8_LDB(B0, 0, 0); PG8_LDB(B1, 0, 1); PG8_SCHED; PG8_LDA(At, 0, 0); PG8_STAGE(PG8_SA(1, 1), a1 + hstep, voffA);
            PG8_WAIT_V(8); PG8_WAIT_L(0); PG8_BAR; PG8_MMA(0, 0, At, B0); PG8_MMA(0, 1, At, B1); PG8_BAR; PG8_SCHED;
            PG8_LDA(At, 0, 1); PG8_STAGE(PG8_SB(0, 0), b2, voffB); PG8_STAGE(PG8_SB(0, 1), b2 + hstep, voffB); PG8_STAGE(PG8_SA(0, 0), a2, voffA);
            PG8_WAIT_V(8); PG8_WAIT_L(0); PG8_BAR; PG8_MMA(1, 0, At, B0); PG8_MMA(1, 1, At, B1); PG8_BAR; PG8_SCHED;
            PG8_LDB(B0, 1, 0); PG8_LDB(B1, 1, 1); PG8_SCHED; PG8_LDA(At, 1, 0); PG8_STAGE(PG8_SA(0, 1), a2 + hstep, voffA);
            PG8_WAIT_V(8); PG8_WAIT_L(0); PG8_BAR; PG8_MMA(0, 0, At, B0); PG8_MMA(0, 1, At, B1); PG8_BAR; PG8_SCHED;
            PG8_LDA(At, 1, 1); PG8_STAGE(PG8_SB(1, 0), b3, voffB); PG8_STAGE(PG8_SB(1, 1), b3 + hstep, voffB); PG8_STAGE(PG8_SA(1, 0), a3, voffA);
            PG8_WAIT_V(8); PG8_WAIT_L(0); PG8_BAR; PG8_MMA(1, 0, At, B0); PG8_MMA(1, 1, At, B1); PG8_BAR; PG8_SCHED;
            } else {
            PG8_LDB(B0, 0, 0); PG8_SCHED; PG8_LDA(At, 0, 0); PG8_STAGE(PG8_SA(1, 1), a1 + hstep, voffA);
            PG8_WAIT_L(8); PG8_BAR; PG8_WAIT_L(0); PG8_MMA(0, 0, At, B0); PG8_BAR; PG8_SCHED;
            PG8_LDB(B1, 0, 1); PG8_STAGE(PG8_SB(0, 0), b2, voffB);
            PG8_BAR; PG8_WAIT_L(0); PG8_MMA(0, 1, At, B1); PG8_BAR;
            PG8_LDA(At, 0, 1); PG8_STAGE(PG8_SA(0, 0), a2, voffA);
            PG8_BAR; PG8_WAIT_L(0); PG8_MMA(1, 0, At, B0); PG8_BAR; PG8_SCHED;
            PG8_STAGE(PG8_SB(0, 1), b2 + hstep, voffB);
            PG8_WAIT_V(6); PG8_BAR; PG8_MMA(1, 1, At, B1); PG8_BAR;
            PG8_LDB(B0, 1, 0); PG8_SCHED; PG8_LDA(At, 1, 0); PG8_STAGE(PG8_SA(0, 1), a2 + hstep, voffA);
            PG8_WAIT_L(8); PG8_BAR; PG8_WAIT_L(0); PG8_MMA(0, 0, At, B0); PG8_BAR; PG8_SCHED;
            PG8_LDB(B1, 1, 1); PG8_STAGE(PG8_SB(1, 0), b3, voffB);
            PG8_BAR; PG8_WAIT_L(0); PG8_MMA(0, 1, At, B1); PG8_BAR;
            PG8_LDA(At, 1, 1); PG8_STAGE(PG8_SA(1, 0), a3, voffA);
            PG8_BAR; PG8_WAIT_L(0); PG8_MMA(1, 0, At, B0); PG8_BAR; PG8_SCHED;
            PG8_STAGE(PG8_SB(1, 1), b3 + hstep, voffB);
            PG8_WAIT_V(6); PG8_BAR; PG8_MMA(1, 1, At, B1); PG8_BAR;
            }
        }
        if constexpr (ALIGN_EPI) { if (wr == 0) PG8_BAR; }
        if constexpr (!Epi::AFTER_DRAIN) { E(acc, cur, wr, wc, fr, fq); S.done(cur); }
        if (!has_next) break;
#pragma unroll
        for (int a = 0; a < 2; ++a)
#pragma unroll
            for (int b = 0; b < 2; ++b)
#pragma unroll
                for (int m = 0; m < 4; ++m)
#pragma unroll
                    for (int n = 0; n < 2; ++n) acc[a][b][m][n] = (f32x4){0.f, 0.f, 0.f, 0.f};
        cur = nxt; cA = nA; cB = nB; ++ui;
        if constexpr (ALIGN_EPI) { if (wr == 1) PG8_BAR; }
    }
    PG8_WAIT_V(0);
    if constexpr (!ALIGN_EPI) { if (wr == 0) PG8_BAR; }
    PG8_BAR;
    if constexpr (Epi::AFTER_DRAIN) { E.fused(acc, cur, wr, wc, fr, fq, lds, wid, lane); S.done(cur); }
#undef PG8_SA
#undef PG8_SB
#undef PG8_STAGE
#undef PG8_LDA
#undef PG8_LDB
#undef PG8_MMA
#undef PG8_WAIT_V
#undef PG8_WAIT_L
#undef PG8_BAR
#undef PG8_SCHED
}
}

#ifndef PG8_SP2
#define PG8_SP2 true
#endif
#ifndef PG8_ALIGN
#define PG8_ALIGN true
#endif

#define GAS __attribute__((address_space(1)))
#define LAS __attribute__((address_space(3)))
typedef unsigned v4u __attribute__((ext_vector_type(4)));
typedef float f32x4 __attribute__((ext_vector_type(4)));
typedef short bf16x8 __attribute__((ext_vector_type(8)));
typedef GAS unsigned gu32;
typedef GAS unsigned long long gu64;
#define RLX_AGENT __ATOMIC_RELAXED, __HIP_MEMORY_SCOPE_AGENT
#define LDS_WAIT() asm volatile("s_waitcnt lgkmcnt(0)" ::: "memory")
#define VM_WAIT() asm volatile("s_waitcnt vmcnt(0)" ::: "memory")

#define XB_TMO      128
#define XB_XCNT(j)  (256  + 64 * (j))
#define XB_XSUB(j)  (1280 + 64 * (j))
#define XB_XGEN(j)  (2304 + 64 * (j))
#define XB_TOP      3328
#define XB_TOPGEN   3392
#define XCD_BAR_WORDS 3456
#define XB_SPIN_CAP (1u << 18)

__device__ __forceinline__ unsigned xb_ld(unsigned* p)              { return __hip_atomic_load(p, __ATOMIC_RELAXED, __HIP_MEMORY_SCOPE_AGENT); }
__device__ __forceinline__ unsigned xb_add(unsigned* p, unsigned v) { return __hip_atomic_fetch_add(p, v, __ATOMIC_RELAXED, __HIP_MEMORY_SCOPE_AGENT); }
__device__ __forceinline__ unsigned xb_xcc_id() { return (unsigned)__builtin_amdgcn_s_getreg((3 << 11) | 20) & 0xFu; }
#define XB_SPIN(cond, bar) do { unsigned _sp = 0; while (cond) { __builtin_amdgcn_s_sleep(1); \
    if ((++_sp & 255u) == 0u) { if (xb_ld(&(bar)[XB_TMO])) break; if (_sp > XB_SPIN_CAP) { atomicAdd(&(bar)[XB_TMO], 1u); break; } } } } while (0)

struct XcdBarrier {
    unsigned* bar; unsigned x;
    volatile LAS unsigned* st;
};

__device__ __forceinline__ XcdBarrier xcd_barrier_post(unsigned* bar, volatile LAS unsigned* st) {
    XcdBarrier b; b.bar = bar; b.x = xb_xcc_id(); b.st = st;
    if (threadIdx.x == 0) (void)xb_add(&bar[XB_XCNT(b.x)], 1u);
    return b;
}
__device__ __forceinline__ void xcd_barrier_complete(unsigned* bar, unsigned x, unsigned& nloc, unsigned& nx) {
    const unsigned G = gridDim.x * gridDim.y * gridDim.z;
    unsigned sum, cnt, mine, sp = 0u;
    for (;;) {
        sum = 0u; cnt = 0u; mine = 0u;
#pragma unroll
        for (unsigned j = 0; j < 16; ++j) { const unsigned c = xb_ld(&bar[XB_XCNT(j)]); sum += c; cnt += (c > 0u) ? 1u : 0u; mine = (j == x) ? c : mine; }
        if (sum == G) break;
        __builtin_amdgcn_s_sleep(1);
        if ((++sp & 255u) == 0u) { if (xb_ld(&bar[XB_TMO])) break; if (sp > XB_SPIN_CAP) { atomicAdd(&bar[XB_TMO], 1u); break; } }
    }
    nloc = mine > 0u ? mine : 1u; nx = cnt > 0u ? cnt : 1u;
}

__device__ __forceinline__ void xcd_barrier(const XcdBarrier& b) {
    asm volatile("s_waitcnt vmcnt(0)" ::: "memory");
    __syncthreads();
    if (threadIdx.x == 0) {
        unsigned* bar = b.bar;
        __builtin_amdgcn_s_waitcnt(0);
        unsigned nloc = b.st[0], nx = b.st[1];
        if (nloc == 0u) { xcd_barrier_complete(bar, b.x, nloc, nx); b.st[0] = nloc; b.st[1] = nx; }
        const unsigned old = xb_add(&bar[XB_XSUB(b.x)], 1u);
        const unsigned gen = old / nloc;
        if (old + 1u == (gen + 1u) * nloc) {
            __builtin_amdgcn_fence(__ATOMIC_RELEASE, "agent");
            asm volatile("s_waitcnt vmcnt(0)" ::: "memory");
            const unsigned og = xb_add(&bar[XB_TOP], 1u);
            const unsigned tg = og / nx;
            if (og + 1u == (tg + 1u) * nx) xb_add(&bar[XB_TOPGEN], 1u);
            else XB_SPIN(xb_ld(&bar[XB_TOPGEN]) == tg, bar);
            __builtin_amdgcn_fence(__ATOMIC_ACQUIRE, "agent");
            xb_add(&bar[XB_XGEN(b.x)], 1u);
            asm volatile("s_waitcnt vmcnt(0)" ::: "memory");
        } else {
            XB_SPIN(xb_ld(&bar[XB_XGEN(b.x)]) == gen, bar);
            __builtin_amdgcn_fence(__ATOMIC_ACQUIRE, "agent");
            asm volatile("s_waitcnt vmcnt(0)" ::: "memory");
        }
    }
    __syncthreads();
}

#ifndef STEP
#define STEP 3
#endif
#ifndef ONE_LAUNCH
#define ONE_LAUNCH 1
#endif
constexpr int NWAVES = 8;
constexpr int LDS_BYTES = 147456;
constexpr int RING_OFF = 0, RING_BYTES = 131072;
constexpr int MISC_OFF = RING_BYTES + 320;
constexpr int CW_BAR = 4096;
constexpr size_t CTL_ZERO_BYTES = 64 * 1024;

struct Frame {
    LAS unsigned char* lds;
    volatile LAS unsigned* MISC;
    int tid, lane, wave, vcu, G;
};

__device__ __forceinline__ float wave_sum(float v) {
#pragma unroll
    for (int o = 1; o < 64; o <<= 1) v += __shfl_xor(v, o);
    return v;
}
__device__ __forceinline__ unsigned pk2(float lo, float hi) { return f2bf(lo) | (f2bf(hi) << 16); }

__device__ __forceinline__ void p0_transpose_item(const float* __restrict__ W, int K, int Nsrc, int n_src0, bf16_t* __restrict__ WT, int n_dst0, const float* __restrict__ kw,
                                                  LAS float* scr, int kb, int nb, int lane, int ncols_valid) {
    const int k0 = 64 * kb, n0 = 32 * nb;
#pragma unroll 8
    for (int i = 0; i < 32; ++i) { const int kk = 2 * i + (lane >> 5); const int nn = lane & 31;
        float v = 0.f; if (nn < ncols_valid) { v = W[(size_t)(k0 + kk) * Nsrc + n_src0 + n0 + nn]; if (kw) v *= kw[k0 + kk]; }
        scr[kk * 33 + nn] = v; }
    LDS_WAIT(); asm volatile("" ::: "memory");
    const int c = lane & 7;
#pragma unroll
    for (int j = 0; j < 4; ++j) { const int n = (lane >> 3) + 8 * j; const LAS float* s = scr + (8 * c) * 33 + n;
        v4u o; o.x = pk2(s[0 * 33], s[1 * 33]); o.y = pk2(s[2 * 33], s[3 * 33]); o.z = pk2(s[4 * 33], s[5 * 33]); o.w = pk2(s[6 * 33], s[7 * 33]);
        *(GAS v4u*)(WT + (size_t)(n_dst0 + n0 + n) * K + k0 + 8 * c) = o; }
    LDS_WAIT(); asm volatile("" ::: "memory");
}
__device__ __forceinline__ void row_to_bf16(const float* xrow, bf16_t* orow, float* rstd_out, int lane) {
    const GAS f32x4* xr = (const GAS f32x4*)xrow + lane;
    f32x4 v[8]; float s = 0.f;
#pragma unroll
    for (int j = 0; j < 8; ++j) { v[j] = xr[64 * j]; s += (v[j].x * v[j].x + v[j].y * v[j].y) + (v[j].z * v[j].z + v[j].w * v[j].w); }
    s = wave_sum(s);
    GAS unsigned long long* o8 = (GAS unsigned long long*)orow + lane;
#pragma unroll
    for (int j = 0; j < 8; ++j) o8[64 * j] = (unsigned long long)pk2(v[j].x, v[j].y) | ((unsigned long long)pk2(v[j].z, v[j].w) << 32);
    if (lane == 0) *rstd_out = 1.0f / sqrtf(s * (1.f / DM) + EPS);
}


typedef float f32x16 __attribute__((ext_vector_type(16)));
typedef short s16x4 __attribute__((ext_vector_type(4)));
typedef short v4i16_t __attribute__((ext_vector_type(4)));
__device__ __forceinline__ int crow(int r, int h) { return (r & 3) + 8 * (r >> 2) + 4 * h; }
__device__ __forceinline__ unsigned cvtpk(float lo, float hi) { typedef float f2 __attribute__((ext_vector_type(2))); typedef __bf16 b2 __attribute__((ext_vector_type(2)));
    f2 v = {lo, hi}; b2 b = __builtin_convertvector(v, b2); return __builtin_bit_cast(unsigned, b); }
__device__ __forceinline__ bf16x8 frag_row(const LAS unsigned char* tile, int pitch, int row0, int kbyte0, int lane) {
    return *(const LAS bf16x8*)(tile + (row0 + (lane & 31)) * pitch + kbyte0 + 16 * (lane >> 5));
}
__device__ __forceinline__ bf16x8 frag_tr(const LAS unsigned char* tile, int pitch, int kb_lo, int kb_step, int col0, int lane) {
    const LAS unsigned char* p = tile + (kb_lo + ((lane & 15) >> 2)) * pitch + (col0 + 16 * ((lane >> 4) & 1) + 4 * (lane & 3)) * 2;
    const s16x4 lo = __builtin_bit_cast(s16x4, __builtin_amdgcn_ds_read_tr16_b64_v4i16((LAS v4i16_t*)p));
    const s16x4 hi = __builtin_bit_cast(s16x4, __builtin_amdgcn_ds_read_tr16_b64_v4i16((LAS v4i16_t*)(p + kb_step * pitch)));
    return (bf16x8){lo[0], lo[1], lo[2], lo[3], hi[0], hi[1], hi[2], hi[3]};
}
__device__ __forceinline__ bf16x8 acc_frag(const f32x16& X, int s) {
    v4u w; w.x = cvtpk(X[8 * s + 0], X[8 * s + 1]); w.y = cvtpk(X[8 * s + 2], X[8 * s + 3]); w.z = cvtpk(X[8 * s + 4], X[8 * s + 5]); w.w = cvtpk(X[8 * s + 6], X[8 * s + 7]);
    return __builtin_bit_cast(bf16x8, w);
}
#define MFMA32(a, b, c) __builtin_amdgcn_mfma_f32_32x32x16_bf16((a), (b), (c), 0, 0, 0)

constexpr int KPITCH = 144, VPITCH = 192;
constexpr float LOG2E = 1.4426950408889634f;

template <int NT, bool DIL>
__device__ __forceinline__ void attn_wave(const LAS unsigned char* Kt, const LAS unsigned char* Vt, int krow0, const bf16x8 (&qf)[4], const LAS float* Tb, int ksub0, int lane,
                                          f32x16 (&o)[2], float& m_out, float& l_out) {
    const int q = lane & 31, h = lane >> 5;
    float m = -1e30f;
#pragma unroll 1
    for (int kt = 0; kt < NT; ++kt) {
        f32x16 X = {};
#pragma unroll
        for (int d0 = 0; d0 < 4; ++d0) X = MFMA32(frag_row(Kt, KPITCH, krow0 + 32 * kt, 32 * d0, lane), qf[d0], X);
        float tm = -1e30f;
#pragma unroll
        for (int r = 0; r < 16; ++r) {
            float s = X[r];
            if (DIL) { const int key = crow(r, h); const int dist = 128 - 32 * kt + q - key; const bool ok = (dist >= 0) && (dist <= 128) && (ksub0 + 32 * kt + key >= 0);
                const int di = dist < 0 ? 0 : (dist > 128 ? 128 : dist); s = ok ? s + Tb[di] : -1e30f; }
            tm = fmaxf(tm, s);
        }
        m = fmaxf(m, tm);
    }
    m = fmaxf(m, __shfl_xor(m, 32));
    float l = 0.f; o[0] = (f32x16){}; o[1] = (f32x16){};
    const float mb = m * LOG2E;
#pragma unroll 1
    for (int kt = 0; kt < NT; ++kt) {
        f32x16 X = {};
#pragma unroll
        for (int d0 = 0; d0 < 4; ++d0) X = MFMA32(frag_row(Kt, KPITCH, krow0 + 32 * kt, 32 * d0, lane), qf[d0], X);
#pragma unroll
        for (int r = 0; r < 16; ++r) {
            float s = X[r]; bool ok = true;
            if (DIL) { const int key = crow(r, h); const int dist = 128 - 32 * kt + q - key; ok = (dist >= 0) && (dist <= 128) && (ksub0 + 32 * kt + key >= 0);
                const int di = dist < 0 ? 0 : (dist > 128 ? 128 : dist); s = s + Tb[di]; }
            const float p = ok ? __builtin_amdgcn_exp2f(s * LOG2E - mb) : 0.f;
            l += p; X[r] = p;
        }
#pragma unroll
        for (int s2 = 0; s2 < 2; ++s2) { const bf16x8 pf = acc_frag(X, s2);
#pragma unroll
            for (int db = 0; db < 2; ++db) o[db] = MFMA32(frag_tr(Vt, VPITCH, krow0 + 32 * kt + 16 * s2 + 4 * h, 8, 32 * db, lane), pf, o[db]); }
    }
    l += __shfl_xor(l, 32);
    m_out = m; l_out = l;
}

template <class RowFn>
__device__ __forceinline__ void stage_kv(LAS unsigned char* Kt, LAS unsigned char* Vt, const bf16_t* gK, const bf16_t* gV, int gpitch, int nrows, int tid, RowFn grow) {
    for (int i = tid; i < nrows * 8; i += NWAVES * 64) { const int row = i >> 3, ch = i & 7; const long g = grow(row);
        v4u kv = {0u, 0u, 0u, 0u}, vv = {0u, 0u, 0u, 0u};
        if (g >= 0) { kv = *(const GAS v4u*)(gK + (size_t)g * gpitch + ch * 8); vv = *(const GAS v4u*)(gV + (size_t)g * gpitch + ch * 8); }
        *(LAS v4u*)(Kt + row * KPITCH + ch * 16) = kv; *(LAS v4u*)(Vt + row * VPITCH + ch * 16) = vv; }
}

constexpr int ATT_K_OFF = 0, ATT_V_OFF = 384 * KPITCH, ATT_T_OFF = ATT_V_OFF + 384 * VPITCH;
constexpr int N_DIL_UNITS = 3 * 2 * 12 * 16, N_MEM_UNITS = 2 * 4 * 16;

__device__ __forceinline__ void dil_attn_unit(Frame& F, unsigned char* ws, int u) {
    const int j = u & 15, hd = (u >> 4) % 12, b = ((u >> 4) / 12) & 1, p = (u >> 4) / 24;
    const int dil = p == 0 ? 1 : (p == 1 ? 4 : 16), nblk = 16 / dil;
    const int cls = j / nblk, blk = j % nblk, l0 = blk * 256;
    LAS unsigned char* Kt = F.lds + ATT_K_OFF; LAS unsigned char* Vt = F.lds + ATT_V_OFF; LAS float* Tb = (LAS float*)(F.lds + ATT_T_OFF);
    const bf16_t* gQ = (const bf16_t*)(ws + WS_DQ) + hd * 64; const bf16_t* gK = (const bf16_t*)(ws + WS_DK) + hd * 64; const bf16_t* gV = (const bf16_t*)(ws + WS_DV) + hd * 64;
    const long rowb = (long)b * SEQ;
    stage_kv(Kt, Vt, gK, gV, 768, 384, F.tid, [&](int row) -> long { const int ls = l0 - 128 + row; return ls < 0 ? -1L : rowb + (long)ls * dil + cls; });
    if (F.tid < 132) Tb[F.tid] = ((const float*)(ws + WS_BIAS))[(p * 12 + hd) * 132 + F.tid];
    const int q = F.lane & 31, h = F.lane >> 5;
    const int qsub0 = l0 + 32 * F.wave;
    const long mrow = rowb + (long)(qsub0 + q) * dil + cls;
    bf16x8 qf[4];
#pragma unroll
    for (int d0 = 0; d0 < 4; ++d0) qf[d0] = *(const GAS bf16x8*)(gQ + (size_t)mrow * 768 + 16 * d0 + 8 * h);
    __syncthreads();
    f32x16 o[2]; float m, l;
    attn_wave<5, true>(Kt, Vt, 32 * F.wave, qf, Tb, qsub0 - 128, F.lane, o, m, l);
    const float inv = 1.f / l;
    bf16_t* O = (bf16_t*)(ws + WS_OP) + (size_t)p * M * 768 + (size_t)mrow * 768 + hd * 64;
#pragma unroll
    for (int db = 0; db < 2; ++db)
#pragma unroll
        for (int g = 0; g < 4; ++g) { const unsigned w0 = cvtpk(o[db][4 * g] * inv, o[db][4 * g + 1] * inv), w1 = cvtpk(o[db][4 * g + 2] * inv, o[db][4 * g + 3] * inv);
            *(GAS unsigned long long*)(O + 32 * db + 8 * g + 4 * h) = (unsigned long long)w0 | ((unsigned long long)w1 << 32); }
    if (h == 0) ((float*)(ws + WS_LSE))[((size_t)p * M + mrow) * 12 + hd] = m + __logf(l);
    __syncthreads();
}

__device__ __forceinline__ void mem_attn_unit(Frame& F, unsigned char* ws, int u) {
    const int blk = u & 15, hm = (u >> 4) & 3, b = u >> 6;
    LAS unsigned char* Kt = F.lds + ATT_K_OFF; LAS unsigned char* Vt = F.lds + ATT_V_OFF;
    const bf16_t* gQ = (const bf16_t*)(ws + WS_MQ) + hm * 64; const bf16_t* gK = (const bf16_t*)(ws + WS_MK) + hm * 64; const bf16_t* gV = (const bf16_t*)(ws + WS_MV) + hm * 64;
    stage_kv(Kt, Vt, gK, gV, 256, 256, F.tid, [&](int row) -> long { return (long)b * MEML + row; });
    const int q = F.lane & 31, h = F.lane >> 5;
    const long mrow = (long)b * SEQ + blk * 256 + 32 * F.wave + q;
    bf16x8 qf[4];
#pragma unroll
    for (int d0 = 0; d0 < 4; ++d0) qf[d0] = *(const GAS bf16x8*)(gQ + (size_t)mrow * 256 + 16 * d0 + 8 * h);
    __syncthreads();
    f32x16 o[2]; float m, l;
    attn_wave<8, false>(Kt, Vt, 0, qf, nullptr, 0, F.lane, o, m, l);
    const float inv = 1.f / l;
    const bf16_t* SG = (const bf16_t*)(ws + WS_SG) + (size_t)mrow * 2048 + 1792 + hm * 64; bf16_t* O = (bf16_t*)(ws + WS_MIXG) + (size_t)mrow * 2048 + 1792 + hm * 64;
#pragma unroll
    for (int db = 0; db < 2; ++db)
#pragma unroll
        for (int g = 0; g < 4; ++g) { const int c = 32 * db + 8 * g + 4 * h; const unsigned long long sg = *(const GAS unsigned long long*)(SG + c);
            const float g0 = bf2f((unsigned short)sg), g1 = bf2f((unsigned short)(sg >> 16)), g2 = bf2f((unsigned short)(sg >> 32)), g3 = bf2f((unsigned short)(sg >> 48));
            const unsigned w0 = cvtpk(o[db][4 * g] * inv * g0, o[db][4 * g + 1] * inv * g1), w1 = cvtpk(o[db][4 * g + 2] * inv * g2, o[db][4 * g + 3] * inv * g3);
            *(GAS unsigned long long*)(O + c) = (unsigned long long)w0 | ((unsigned long long)w1 << 32); }
    __syncthreads();
}

constexpr int GQT_PITCH = 272, GKS_PITCH = 320, GV_PITCH = 576, GOT_PITCH = 1040;
constexpr int N_GLA_UNITS = 8 * 64;
__device__ __forceinline__ void gla_a_unit(Frame& F, unsigned char* ws, const float* __restrict__ w2, const float* __restrict__ bg, int u) {
    const int n = u & 63, bh = u >> 6, b = bh >> 2, hg = bh & 3;
    const size_t m0 = (size_t)b * SEQ + 64 * n;
    LAS float* GL = (LAS float*)(F.lds);
    LAS float* GS = (LAS float*)(F.lds + 4096);
    LAS unsigned char* KS = F.lds + 8192;
    LAS unsigned char* VT = F.lds + 8192 + 64 * GKS_PITCH;
    bf16_t* GQ = (bf16_t*)(ws + WS_GQ); bf16_t* GK = (bf16_t*)(ws + WS_GK); const bf16_t* GV = (const bf16_t*)(ws + WS_GV);
    if (F.tid < 256) *(LAS f32x4*)(GL + 4 * F.tid) = *(const GAS f32x4*)((const float*)(ws + WS_GLR) + m0 * 16 + 4 * F.tid);
    for (int i = F.tid; i < 64 * 32; i += NWAVES * 64) { const int row = i >> 5, ch = i & 31;
        *(LAS v4u*)(VT + row * GV_PITCH + ch * 16) = *(const GAS v4u*)(GV + (m0 + row) * 1024 + hg * 256 + ch * 8); }
    const int c = F.tid & 127, tg = F.tid >> 7;
    float wc[16];
#pragma unroll
    for (int jj = 0; jj < 16; ++jj) wc[jj] = w2[jj * 512 + hg * 128 + c];
    const float bgc = bg[hg * 128 + c];
    __syncthreads();
    float bl[16]; float cum = 0.f;
#pragma unroll
    for (int tt = 0; tt < 16; ++tt) { const int t = tg * 16 + tt; float z = bgc;
#pragma unroll
        for (int j4 = 0; j4 < 4; ++j4) { const f32x4 g = *(const LAS f32x4*)(GL + t * 16 + 4 * j4); z += g[0] * wc[4 * j4] + g[1] * wc[4 * j4 + 1] + g[2] * wc[4 * j4 + 2] + g[3] * wc[4 * j4 + 3]; }
        const float ls = fminf(z, 0.f) - log1pf(__expf(-fabsf(z)));
        cum += ls * (1.f / 16.f); bl[tt] = cum; }
    GS[tg * 128 + c] = cum;
    __syncthreads();
    float off = 0.f, blast = 0.f;
#pragma unroll
    for (int g = 0; g < 4; ++g) { const float s = GS[g * 128 + c]; blast += s; if (g < tg) off += s; }
#pragma unroll
    for (int tt = 0; tt < 16; ++tt) { const int t = tg * 16 + tt; const float bt = off + bl[tt]; const size_t gi = (m0 + t) * 512 + hg * 128 + c;
        const float qv = bf2f(GQ[gi]), kv = bf2f(GK[gi]);
        GQ[gi] = (bf16_t)f2bf(qv * __expf(bt)); GK[gi] = (bf16_t)f2bf(kv * __expf(-bt));
        *(LAS bf16_t*)(KS + t * GKS_PITCH + c * 2) = (bf16_t)f2bf(kv * __expf(blast - bt)); }
    if (tg == 0) ((float*)(ws + WS_DEC))[(size_t)u * 128 + c] = __expf(blast);
    __syncthreads();
    const int h = F.lane >> 5;
    f32x16 acc[4] = {};
#pragma unroll
    for (int s = 0; s < 4; ++s) { const bf16x8 a = frag_tr(VT, GV_PITCH, 16 * s + 8 * h, 4, 32 * F.wave, F.lane);
#pragma unroll
        for (int cb = 0; cb < 4; ++cb) acc[cb] = MFMA32(a, frag_tr(KS, GKS_PITCH, 16 * s + 8 * h, 4, 32 * cb, F.lane), acc[cb]); }
    bf16_t* KV = (bf16_t*)(ws + WS_KV) + (size_t)u * 256 * 128;
#pragma unroll
    for (int cb = 0; cb < 4; ++cb)
#pragma unroll
        for (int r = 0; r < 16; ++r) KV[(size_t)(32 * F.wave + crow(r, h)) * 128 + 32 * cb + (F.lane & 31)] = (bf16_t)f2bf(acc[cb][r]);
    __syncthreads();
}
__device__ __forceinline__ void gla_scan_item(unsigned char* ws, int i) {
    const int c8 = i & 15, v = (i >> 4) & 255, bh = i >> 12;
    const bf16_t* KV = (const bf16_t*)(ws + WS_KV) + ((size_t)bh * 64 * 256 + v) * 128 + 8 * c8;
    bf16_t* SN = (bf16_t*)(ws + WS_SN) + ((size_t)bh * 64 * 256 + v) * 128 + 8 * c8;
    const float* DEC = (const float*)(ws + WS_DEC) + (size_t)bh * 64 * 128 + 8 * c8;
    float S[8] = {};
#pragma unroll 4
    for (int n = 0; n < 63; ++n) {
        const v4u kv = *(const GAS v4u*)(KV + (size_t)n * 256 * 128);
        const f32x4 d0 = *(const GAS f32x4*)(DEC + n * 128), d1 = *(const GAS f32x4*)(DEC + n * 128 + 4);
        S[0] = d0[0] * S[0] + bf2f((unsigned short)kv.x); S[1] = d0[1] * S[1] + bf2f((unsigned short)(kv.x >> 16));
        S[2] = d0[2] * S[2] + bf2f((unsigned short)kv.y); S[3] = d0[3] * S[3] + bf2f((unsigned short)(kv.y >> 16));
        S[4] = d1[0] * S[4] + bf2f((unsigned short)kv.z); S[5] = d1[1] * S[5] + bf2f((unsigned short)(kv.z >> 16));
        S[6] = d1[2] * S[6] + bf2f((unsigned short)kv.w); S[7] = d1[3] * S[7] + bf2f((unsigned short)(kv.w >> 16));
        v4u o; o.x = pk2(S[0], S[1]); o.y = pk2(S[2], S[3]); o.z = pk2(S[4], S[5]); o.w = pk2(S[6], S[7]);
        *(GAS v4u*)(SN + (size_t)(n + 1) * 256 * 128) = o;
    }
}
__device__ __forceinline__ void gla_c_unit(Frame& F, unsigned char* ws, const float* __restrict__ gnw, int u) {
    const int n = u & 63, bh = u >> 6, b = bh >> 2, hg = bh & 3;
    const size_t m0 = (size_t)b * SEQ + 64 * n;
    LAS unsigned char* QT = F.lds; LAS unsigned char* KT = F.lds + 64 * GQT_PITCH; LAS unsigned char* VT = F.lds + 128 * GQT_PITCH;
    LAS float* RED = (LAS float*)(F.lds + 128 * GQT_PITCH + 64 * GV_PITCH);
    LAS unsigned char* OT = F.lds;
    const bf16_t* GQ = (const bf16_t*)(ws + WS_GQ); const bf16_t* GK = (const bf16_t*)(ws + WS_GK); const bf16_t* GV = (const bf16_t*)(ws + WS_GV);
    for (int i = F.tid; i < 64 * 16; i += NWAVES * 64) { const int row = i >> 4, ch = i & 15; const size_t gi = (m0 + row) * 512 + hg * 128 + ch * 8;
        *(LAS v4u*)(QT + row * GQT_PITCH + ch * 16) = *(const GAS v4u*)(GQ + gi); *(LAS v4u*)(KT + row * GQT_PITCH + ch * 16) = *(const GAS v4u*)(GK + gi); }
    for (int i = F.tid; i < 64 * 32; i += NWAVES * 64) { const int row = i >> 5, ch = i & 31;
        *(LAS v4u*)(VT + row * GV_PITCH + ch * 16) = *(const GAS v4u*)(GV + (m0 + row) * 1024 + hg * 256 + ch * 8); }
    __syncthreads();
    const int q = F.lane & 31, h = F.lane >> 5, tb = F.wave & 1, vs = F.wave >> 1;
    f32x16 X[2] = {};
#pragma unroll
    for (int kt = 0; kt < 2; ++kt) if (kt <= tb) {
#pragma unroll
        for (int s = 0; s < 8; ++s) X[kt] = MFMA32(frag_row(KT, GQT_PITCH, 32 * kt, 32 * s, F.lane), frag_row(QT, GQT_PITCH, 32 * tb, 32 * s, F.lane), X[kt]);
        if (kt == tb) {
#pragma unroll
            for (int r = 0; r < 16; ++r) if (crow(r, h) > q) X[kt][r] = 0.f;
        }
    }
    f32x16 o[2] = {};
    const bf16_t* SN = (const bf16_t*)(ws + WS_SN) + (size_t)u * 256 * 128;
#pragma unroll
    for (int vb = 0; vb < 2; ++vb) { const int V = 2 * vs + vb;
#pragma unroll
        for (int kt = 0; kt < 2; ++kt) if (kt <= tb) {
#pragma unroll
            for (int s2 = 0; s2 < 2; ++s2) o[vb] = MFMA32(frag_tr(VT, GV_PITCH, 32 * kt + 16 * s2 + 4 * h, 8, 32 * V, F.lane), acc_frag(X[kt], s2), o[vb]); }
        if (n > 0) {
#pragma unroll
            for (int s = 0; s < 8; ++s) { const bf16x8 a = *(const GAS bf16x8*)(SN + (size_t)(32 * V + q) * 128 + 16 * s + 8 * h);
                o[vb] = MFMA32(a, frag_row(QT, GQT_PITCH, 32 * tb, 32 * s, F.lane), o[vb]); } }
    }
    float ss = 0.f;
#pragma unroll
    for (int vb = 0; vb < 2; ++vb)
#pragma unroll
        for (int r = 0; r < 16; ++r) ss += o[vb][r] * o[vb][r];
    ss += __shfl_xor(ss, 32);
    if (h == 0) RED[vs * 64 + 32 * tb + q] = ss;
    __syncthreads();
    const int tok = 32 * tb + q;
    const float tot = RED[tok] + RED[64 + tok] + RED[128 + tok] + RED[192 + tok];
    const float rstd = 1.0f / sqrtf(tot * (1.f / 256.f) + EPS);
#pragma unroll
    for (int vb = 0; vb < 2; ++vb)
#pragma unroll
        for (int g = 0; g < 4; ++g) { const int v0 = 32 * (2 * vs + vb) + 8 * g + 4 * h; const f32x4 w = *(const GAS f32x4*)(gnw + v0);
            f32x4 val; val[0] = o[vb][4 * g] * rstd * w[0]; val[1] = o[vb][4 * g + 1] * rstd * w[1]; val[2] = o[vb][4 * g + 2] * rstd * w[2]; val[3] = o[vb][4 * g + 3] * rstd * w[3];
            *(LAS f32x4*)(OT + tok * GOT_PITCH + v0 * 4) = val; }
    __syncthreads();
    for (int i = F.tid; i < 64 * 32; i += NWAVES * 64) { const int row = i >> 5, ch = i & 31; const size_t gi = (m0 + row) * 2048 + 768 + hg * 256 + ch * 8;
        const f32x4 a = *(const LAS f32x4*)(OT + row * GOT_PITCH + ch * 32), bq = *(const LAS f32x4*)(OT + row * GOT_PITCH + ch * 32 + 16);
        const v4u sg = *(const GAS v4u*)((const bf16_t*)(ws + WS_SG) + gi);
        v4u w; w.x = pk2(a[0] * bf2f((unsigned short)sg.x), a[1] * bf2f((unsigned short)(sg.x >> 16))); w.y = pk2(a[2] * bf2f((unsigned short)sg.y), a[3] * bf2f((unsigned short)(sg.y >> 16)));
        w.z = pk2(bq[0] * bf2f((unsigned short)sg.z), bq[1] * bf2f((unsigned short)(sg.z >> 16))); w.w = pk2(bq[2] * bf2f((unsigned short)sg.w), bq[3] * bf2f((unsigned short)(sg.w >> 16)));
        *(GAS v4u*)((bf16_t*)(ws + WS_MIXG) + gi) = w; }
    __syncthreads();
}

__device__ __forceinline__ void dil_combine_item(unsigned char* ws, int i) {
    const int c8 = i % 96, m = i / 96, hd = c8 >> 3;
    const float* LSE = (const float*)(ws + WS_LSE);
    const float l0 = LSE[((size_t)0 * M + m) * 12 + hd], l1 = LSE[((size_t)1 * M + m) * 12 + hd], l2 = LSE[((size_t)2 * M + m) * 12 + hd];
    const float mx = fmaxf(l0, fmaxf(l1, l2));
    float w0 = __expf(l0 - mx), w1 = __expf(l1 - mx), w2 = __expf(l2 - mx); const float inv = 1.f / (w0 + w1 + w2); w0 *= inv; w1 *= inv; w2 *= inv;
    const bf16_t* OP = (const bf16_t*)(ws + WS_OP) + (size_t)m * 768 + c8 * 8;
    const v4u a = *(const GAS v4u*)OP, bb = *(const GAS v4u*)(OP + (size_t)M * 768), cc = *(const GAS v4u*)(OP + (size_t)2 * M * 768);
    const v4u sg = *(const GAS v4u*)((const bf16_t*)(ws + WS_SG) + (size_t)m * 2048 + c8 * 8);
    v4u o;
#define CMB(f) { const float lo = (w0 * bf2f((unsigned short)a.f) + w1 * bf2f((unsigned short)bb.f) + w2 * bf2f((unsigned short)cc.f)) * bf2f((unsigned short)sg.f); \
                 const float hi = (w0 * bf2f((unsigned short)(a.f >> 16)) + w1 * bf2f((unsigned short)(bb.f >> 16)) + w2 * bf2f((unsigned short)(cc.f >> 16))) * bf2f((unsigned short)(sg.f >> 16)); o.f = pk2(lo, hi); }
    CMB(x) CMB(y) CMB(z) CMB(w)
#undef CMB
    *(GAS v4u*)((bf16_t*)(ws + WS_MIXG) + (size_t)m * 2048 + c8 * 8) = o;
}
__device__ __forceinline__ void final_row(const float* xrow, const float* yrow, const float* w, float* orow, int lane) {
    const GAS f32x4* yr = (const GAS f32x4*)yrow + lane; const GAS f32x4* xr = (const GAS f32x4*)xrow + lane; const GAS f32x4* wr = (const GAS f32x4*)w + lane;
    f32x4 v[8]; float s = 0.f;
#pragma unroll
    for (int j = 0; j < 8; ++j) { v[j] = yr[64 * j]; s += (v[j].x * v[j].x + v[j].y * v[j].y) + (v[j].z * v[j].z + v[j].w * v[j].w); }
    s = wave_sum(s);
    const float r = 1.0f / sqrtf(s * (1.f / DM) + EPS);
    GAS f32x4* o = (GAS f32x4*)orow + lane;
#pragma unroll
    for (int j = 0; j < 8; ++j) o[64 * j] = xr[64 * j] + v[j] * r * wr[64 * j];
}
struct Args { const float* in[12]; float* out; unsigned char* ws; int ph_lo, ph_hi; };

__device__ __forceinline__ void p0_prologue(Frame& F, const Args& a) {
    LAS float* scr = (LAS float*)(F.lds + RING_OFF + F.wave * 16384);
    const int gw = F.vcu * NWAVES + F.wave, NGW = F.G * NWAVES;
    unsigned char* ws = a.ws;
    bf16_t* WinT = (bf16_t*)(ws + WS_WIN); bf16_t* WoutT = (bf16_t*)(ws + WS_WOUT); bf16_t* WmemT = (bf16_t*)(ws + WS_WMEM);
    const float* w_in = a.in[3]; const float* npre = a.in[2]; const float* wmem = a.in[9]; const float* mnw = a.in[8]; const float* wout = a.in[10];
    constexpr int KB = DM / 64;
    constexpr int NB_A = 4352 / 32, NB_B = 2304 / 32, NB_C = 1, NB_MEM = 512 / 32, NB_OUT = 2048 / 32;
    constexpr int I_A = KB * NB_A, I_B = KB * NB_B, I_C = KB * NB_C, I_M = KB * NB_MEM, I_O = KB * NB_OUT;
    constexpr int NITEMS = I_A + I_B + I_C + I_M + I_O;
    for (int it = gw; it < NITEMS; it += NGW) {
        int r = it;
        if (r < I_A) { p0_transpose_item(w_in, DM, NPROJ, 0, WinT, 0, npre, scr, r / NB_A, r % NB_A, F.lane, 32); continue; } r -= I_A;
        if (r < I_B) { p0_transpose_item(w_in, DM, NPROJ, C_MQ, WinT, 4352, npre, scr, r / NB_B, r % NB_B, F.lane, 32); continue; } r -= I_B;
        if (r < I_C) { p0_transpose_item(w_in, DM, NPROJ, C_LR, WinT, 6656, npre, scr, r, 0, F.lane, 16); continue; } r -= I_C;
        if (r < I_M) { p0_transpose_item(wmem, DM, 512, 0, WmemT, 0, mnw, scr, r / NB_MEM, r % NB_MEM, F.lane, 32); continue; } r -= I_M;
        p0_transpose_item(wout, D_MIX, DM, 0, WoutT, 0, nullptr, scr, r / NB_OUT, r % NB_OUT, F.lane, 32);
    }
    { const int gt = F.vcu * (NWAVES * 64) + F.tid, NT = F.G * NWAVES * 64; GAS v4u* z = (GAS v4u*)(WinT + (size_t)6688 * DM);
      const int n16 = (6912 - 6688) * DM * 2 / 16;
      for (int i = gt; i < n16; i += NT) z[i] = (v4u){0u, 0u, 0u, 0u}; }
    bf16_t* xb = (bf16_t*)(ws + WS_XB); float* rstdx = (float*)(ws + WS_RSTDX);
    for (int m = gw; m < M; m += NGW) row_to_bf16(a.in[0] + (size_t)m * DM, xb + (size_t)m * DM, rstdx + m, F.lane);
    bf16_t* memb = (bf16_t*)(ws + WS_MEMB); float* rstdm = (float*)(ws + WS_RSTDM);
    for (int m = gw; m < 512; m += NGW) row_to_bf16(a.in[1] + (size_t)m * DM, memb + (size_t)m * DM, rstdm + m, F.lane);
    { const int gt = F.vcu * (NWAVES * 64) + F.tid, NT = F.G * NWAVES * 64; float* T = (float*)(ws + WS_BIAS); const float* rel_bias = a.in[4];
      for (int i = gt; i < 3 * 12 * 132; i += NT) { const int rel = i % 132, h = (i / 132) % 12, p = i / (132 * 12); const int dil = p == 0 ? 1 : (p == 1 ? 4 : 16);
          T[i] = rel <= 128 ? rel_bias[t5_bucket(rel * dil) * 12 + h] : 0.f; } }
}

__global__ void __launch_bounds__(NWAVES * 64, 2) fwd(Args args) {
    __shared__ __attribute__((aligned(16))) unsigned char lds_raw[LDS_BYTES];
    Frame F;
    F.lds = (LAS unsigned char*)lds_raw;
    F.MISC = (volatile LAS unsigned*)(F.lds + MISC_OFF);
    F.tid = threadIdx.x; F.lane = F.tid & 63; F.wave = __builtin_amdgcn_readfirstlane(F.tid >> 6);
    F.G = gridDim.x; { const int bx = blockIdx.x; F.vcu = (F.G % 8 == 0) ? (bx % 8) * (F.G / 8) + bx / 8 : bx; }
    unsigned char* ws = args.ws;
    gu32* ctl = (gu32*)(ws + WS_CTL);
    for (int u = F.tid; u < (LDS_BYTES - RING_BYTES) / 4; u += NWAVES * 64) ((LAS unsigned*)(F.lds + RING_BYTES))[u] = 0u;
    __syncthreads();
    const int lo = args.ph_lo, hi = args.ph_hi;
    const bool multi = (hi - lo) > 1;
    XcdBarrier bar; bar.bar = (unsigned*)(ctl + CW_BAR); bar.x = 0; bar.st = nullptr;
    if (multi) bar = xcd_barrier_post((unsigned*)(ctl + CW_BAR), F.MISC + 8);
#define IN(k) (lo <= (k) && (k) < hi)
#define BOTH(k) (IN(k) && IN((k) + 1))
    if (IN(0)) { p0_prologue(F, args); if (BOTH(0)) xcd_barrier(bar); }
    if (IN(1)) {
        { pg8::Gemm g{(const pg8::bf16_t*)(ws + WS_XB), (const pg8::bf16_t*)(ws + WS_WIN), M, 6912, DM}; pg8::StaticOrder S; S.init(M, 6912, F.G, (int)blockIdx.x);
          pg8::EpiProj E{ws, (const float*)(ws + WS_RSTDX)};
          pg8::gemm_phase<pg8::EpiProj, pg8::StaticOrder, PG8_ALIGN, PG8_SP2>(F.lds + RING_OFF, g, S, E); }
        { pg8::Gemm g{(const pg8::bf16_t*)(ws + WS_MEMB), (const pg8::bf16_t*)(ws + WS_WMEM), 512, 512, DM}; pg8::StaticOrder S; S.init(512, 512, F.G, (int)blockIdx.x);
          pg8::EpiMemKV E{ws, (const float*)(ws + WS_RSTDM)};
          pg8::gemm_phase<pg8::EpiMemKV, pg8::StaticOrder, PG8_ALIGN, PG8_SP2>(F.lds + RING_OFF, g, S, E); }
        if (BOTH(1)) xcd_barrier(bar);
    }
    if (IN(2)) {
        for (int u = F.vcu; u < N_DIL_UNITS; u += F.G) dil_attn_unit(F, ws, u);
        for (int u = F.vcu; u < N_MEM_UNITS; u += F.G) mem_attn_unit(F, ws, u);
#if STEP >= 2
        for (int u = F.vcu; u < N_GLA_UNITS; u += F.G) gla_a_unit(F, ws, args.in[5], args.in[6], u);
#endif
        if (BOTH(2)) xcd_barrier(bar);
    }
    if (IN(3)) {
        if (F.tid < 128) { for (int i = F.vcu * 128 + F.tid; i < 8 * 256 * 16; i += F.G * 128) gla_scan_item(ws, i); }
#if STEP >= 3
        else { for (int i = F.vcu * 384 + (F.tid - 128); i < M * 96; i += F.G * 384) dil_combine_item(ws, i); }
#endif
        if (BOTH(3)) xcd_barrier(bar);
    }
    if (IN(4)) {
        for (int u = F.vcu; u < N_GLA_UNITS; u += F.G) gla_c_unit(F, ws, args.in[7], u);
        if (BOTH(4)) xcd_barrier(bar);
    }
    if (IN(5)) {
        pg8::Gemm g{(const pg8::bf16_t*)(ws + WS_MIXG), (const pg8::bf16_t*)(ws + WS_WOUT), M, DM, D_MIX}; pg8::StaticOrder S; S.init(M, DM, F.G, (int)blockIdx.x);
        pg8::EpiF32 E{(float*)(ws + WS_Y), DM};
        pg8::gemm_phase<pg8::EpiF32, pg8::StaticOrder, PG8_ALIGN, PG8_SP2>(F.lds + RING_OFF, g, S, E);
        if (BOTH(5)) xcd_barrier(bar);
    }
    if (IN(6)) {
        const int gw = F.vcu * NWAVES + F.wave, NGW = F.G * NWAVES;
        for (int m = gw; m < M; m += NGW) final_row(args.in[0] + (size_t)m * DM, (const float*)(ws + WS_Y) + (size_t)m * DM, args.in[11], args.out + (size_t)m * DM, F.lane);
    }
#undef IN
#undef BOTH
}

extern "C" void kernel_launch(void* const* d_in, const int* in_sizes, int n_in, void* d_out, int out_size, void* d_ws, size_t ws_size, hipStream_t stream) {
    static int grid = 0;
    if (grid == 0) {
        int dev = 0, cus = 0;
        if (hipGetDevice(&dev) != hipSuccess || hipDeviceGetAttribute(&cus, hipDeviceAttributeMultiprocessorCount, dev) != hipSuccess) { fprintf(stderr, "kernel_launch: device query failed\n"); grid = -1; return; }
        grid = cus;
    }
    if (grid < 0) return;
    unsigned char* ws = (unsigned char*)d_ws; float* out = (float*)d_out;
    (void)hipMemsetAsync(ws + WS_CTL, 0, CTL_ZERO_BYTES, stream);
    Args a{};
    for (int i = 0; i < 12; ++i) a.in[i] = (const float*)d_in[i];
    a.out = out; a.ws = ws;
#define LAUNCH(lo_, hi_) do { a.ph_lo = (lo_); a.ph_hi = (hi_); hipLaunchKernelGGL(fwd, dim3(grid), dim3(NWAVES * 64), 0, stream, a); } while (0)
#if ONE_LAUNCH
    LAUNCH(0, 7);
#else
    LAUNCH(0, 1); LAUNCH(1, 2); LAUNCH(2, 3); LAUNCH(3, 4); LAUNCH(4, 5); LAUNCH(5, 6); LAUNCH(6, 7);
#endif
}
```

```cpp
#include <hip/hip_runtime.h>
#include <cstdint>
#include <cstdio>
#include <cmath>

constexpr int BATCH = 2, SEQ = 4096, DM = 2048, M = BATCH * SEQ;
constexpr int NH_DIL = 12, HD = 64, D_DIL = 768;
constexpr int NH_GLA = 4, GDK = 128, GDV = 256, GRANK = 16, D_GK = 512, D_GV = 1024;
constexpr int NH_MEM = 4, MEML = 256, D_MEM = 256;
constexpr int D_MIX = 2048, NPROJ = 6672;
constexpr int C_DQ = 0, C_DK = 768, C_DV = 1536, C_GQ = 2304, C_GK = 2816, C_GV = 3328, C_LR = 4352, C_MQ = 4368, C_GATE = 4624;
constexpr float EPS = 1e-6f;

typedef unsigned short bf16_t;
__device__ __forceinline__ unsigned f2bf(float f) { unsigned u = __builtin_bit_cast(unsigned, f); return (u + 0x7fffu + ((u >> 16) & 1u)) >> 16; }
__device__ __forceinline__ float bf2f(unsigned short h) { return __builtin_bit_cast(float, ((unsigned)h) << 16); }
__device__ __forceinline__ float bfround(float f) { return bf2f((unsigned short)f2bf(f)); }

constexpr size_t MiB = 1u << 20;
constexpr size_t WS_CTL = 0;
constexpr size_t WS_RSTDX = 1 * MiB, WS_RSTDM = 1 * MiB + 32 * 1024, WS_BIAS = 1 * MiB + 128 * 1024, WS_DEC = 1 * MiB + 512 * 1024;
constexpr size_t WS_GLR = 2 * MiB, WS_MK = 2 * MiB + 512 * 1024, WS_MV = 2 * MiB + 768 * 1024, WS_LSE = 3 * MiB;
constexpr size_t WS_WOUT = 8 * MiB, WS_WIN = 16 * MiB, WS_WMEM = 43 * MiB, WS_XB = 45 * MiB, WS_MEMB = 77 * MiB;
constexpr size_t WS_DQ = 79 * MiB, WS_DK = 91 * MiB, WS_DV = 103 * MiB, WS_OP = 115 * MiB;
constexpr size_t WS_GQ = 151 * MiB, WS_GK = 159 * MiB, WS_GV = 167 * MiB, WS_MQ = 183 * MiB, WS_SG = 187 * MiB, WS_MIXG = 219 * MiB;
constexpr size_t WS_KV = 16 * MiB, WS_QT = 48 * MiB, WS_KT = 56 * MiB, WS_Y = 82 * MiB;

__device__ __forceinline__ int t5_bucket(int dist) {
    if (dist < 16) return dist;
    const double v = log((double)dist / 16.0) / log(128.0) * 16.0;
    int large = 16 + (int)v;
    return large < 31 ? large : 31;
}

namespace pg8 {
#define PG8_LAS __attribute__((address_space(3)))
typedef unsigned short bf16_t;
typedef short bf16x8 __attribute__((ext_vector_type(8)));
typedef float f32x4 __attribute__((ext_vector_type(4)));
typedef unsigned u32x4 __attribute__((ext_vector_type(4)));
constexpr int BM = 256, BK = 64, HALF = 128, HTB = HALF * BK * 2  , STAGE_BYTES = 8 * HTB, NXCD = 8, WGM = 8;

__host__ __device__ __forceinline__ int lds_byte(int r, int c) { const int st = (r >> 4) * 2 + (c >> 5), rr = r & 15, cc = c & 31, ob = rr * 64 + cc * 2; return st * 1024 + (ob ^ (((ob >> 9) & 1) << 5)); }
__host__ __device__ __forceinline__ void stage_rc(int b, int& R, int& C) { const int st = b / 1024, sb = b % 1024, swz = sb ^ (((sb >> 9) & 1) << 5); R = (st >> 1) * 16 + swz / 64; C = (st & 1) * 32 + (swz % 64) / 2; }
__host__ __device__ __forceinline__ int perm32(int rho) { const int n = rho >> 4, i = rho & 15; return 8 * (i >> 2) + 4 * n + (i & 3); }

struct Unit { int pm, pn; };
struct Gemm { const bf16_t* A; const bf16_t* Bt; int M, N, K; };

struct StaticOrder {
    int nM, nN, nwg, G, c;
    __host__ __device__ void init(int M, int N, int G_, int c_) { nM = M / BM; nN = N / BM; nwg = nM * nN; G = G_; c = c_; }
    __host__ __device__ bool next(int i, Unit& u) const {
        const long L = (long)i * G + c; if (L >= nwg) return false;
        int wgid = (int)L; { const int q = nwg / NXCD, r = nwg % NXCD, xcd = wgid % NXCD, off = wgid / NXCD; wgid = (xcd < r ? xcd * (q + 1) : r * (q + 1) + (xcd - r) * q) + off; }
        const int nig = WGM * nN, gid = wgid / nig, fm = gid * WGM, gsz = (nM - fm) < WGM ? (nM - fm) : WGM;
        u.pm = fm + ((wgid % nig) % gsz); u.pn = (wgid % nig) / gsz; return true;
    }
    __device__ __forceinline__ void a_ready(const Unit&) const {}
    __device__ __forceinline__ void done(const Unit&) const {}
};


__device__ __forceinline__ unsigned cvt_pk_bf16(float lo, float hi) { unsigned r; asm volatile("v_cvt_pk_bf16_f32 %0, %1, %2" : "=v"(r) : "v"(lo), "v"(hi)); return r; }

struct EpiProj {
    static constexpr bool PERM = true, AFTER_DRAIN = false;
    unsigned char* ws; const float* rstd;
    __device__ __forceinline__ void operator()(const f32x4 (&acc)[2][2][4][2], const Unit& u, int wr, int wc, int fr, int fq) const {
        const int row0 = u.pm * BM + wr * 64 + fr; const int t = u.pn;
        bf16_t* base; int ldc, coff; float sc = 1.f; int act = 0;
        if (t < 3)       { base = (bf16_t*)(ws + WS_DQ); ldc = 768;  coff = t * 256;        sc = 0.125f * 1.4426950408889634f; }
        else if (t < 6)  { base = (bf16_t*)(ws + WS_DK); ldc = 768;  coff = (t - 3) * 256; }
        else if (t < 9)  { base = (bf16_t*)(ws + WS_DV); ldc = 768;  coff = (t - 6) * 256; }
        else if (t < 11) { base = (bf16_t*)(ws + WS_GQ); ldc = 512;  coff = (t - 9) * 256;  sc = 0.08838834764831845f; }
        else if (t < 13) { base = (bf16_t*)(ws + WS_GK); ldc = 512;  coff = (t - 11) * 256; }
        else if (t < 17) { base = (bf16_t*)(ws + WS_GV); ldc = 1024; coff = (t - 13) * 256; }
        else if (t == 17){ base = (bf16_t*)(ws + WS_MQ); ldc = 256;  coff = 0;              sc = 0.125f * 1.4426950408889634f; }
        else if (t < 26) { base = (bf16_t*)(ws + WS_SG); ldc = 2048; coff = (t - 18) * 256; act = 1; }
        else if (t == 26){ base = nullptr; ldc = 16; coff = 0; act = 2; }
        else             { base = (bf16_t*)(ws + (t == 27 ? WS_MK : WS_MV)) - (size_t)M * 256; ldc = 256; coff = 0; }
        if (act == 2) {
            if (wc == 0 && fq < 2) {
                float* G = (float*)(ws + WS_GLR);
#pragma unroll
                for (int ai = 0; ai < 2; ++ai)
#pragma unroll
                    for (int m = 0; m < 4; ++m) { const int r = row0 + ai * HALF + m * 16; const float rs = rstd[r];
                        *(f32x4*)(G + (size_t)r * 16 + 8 * fq) = acc[ai][0][m][0] * rs; *(f32x4*)(G + (size_t)r * 16 + 8 * fq + 4) = acc[ai][0][m][1] * rs; }
            }
            return;
        }
        const int col0 = coff + wc * 32 + 8 * fq;
#pragma unroll
        for (int ai = 0; ai < 2; ++ai)
#pragma unroll
            for (int m = 0; m < 4; ++m) { const int r = row0 + ai * HALF + m * 16; const float rs = rstd[r] * sc; bf16_t* rowp = base + (size_t)r * ldc + col0;
#pragma unroll
                for (int bj = 0; bj < 2; ++bj) { f32x4 v0 = acc[ai][bj][m][0] * rs, v1 = acc[ai][bj][m][1] * rs;
                    if (act == 1) {
#pragma unroll
                        for (int i = 0; i < 4; ++i) { v0[i] = v0[i] * __builtin_amdgcn_rcpf(1.f + __expf(-v0[i])); v1[i] = v1[i] * __builtin_amdgcn_rcpf(1.f + __expf(-v1[i])); }
                    }
                    u32x4 w; w.x = cvt_pk_bf16(v0[0], v0[1]); w.y = cvt_pk_bf16(v0[2], v0[3]); w.z = cvt_pk_bf16(v1[0], v1[1]); w.w = cvt_pk_bf16(v1[2], v1[3]);
                    *(u32x4*)(rowp + bj * HALF) = w; } }
    }
};
struct EpiF32 {
    static constexpr bool PERM = false, AFTER_DRAIN = false;
    float* O; int ldc;
    __device__ __forceinline__ void operator()(const f32x4 (&acc)[2][2][4][2], const Unit& u, int wr, int wc, int fr, int fq) const {
        const int row0 = u.pm * BM + wr * 64 + fr, col0 = u.pn * BM + wc * 32 + 4 * fq;
#pragma unroll
        for (int ai = 0; ai < 2; ++ai)
#pragma unroll
            for (int m = 0; m < 4; ++m) { float* rowp = O + (size_t)(row0 + ai * HALF + m * 16) * ldc + col0;
#pragma unroll
                for (int bj = 0; bj < 2; ++bj)
#pragma unroll
                    for (int n = 0; n < 2; ++n) *(f32x4*)(rowp + bj * HALF + n * 16) = acc[ai][bj][m][n]; }
    }
};


struct ProjOrder {
    StaticOrder so; int G, c;
    __host__ __device__ void init(int G_, int c_) { so.init(M, 6912, G_, c_); G = G_; c = c_; }
    __host__ __device__ bool next(int i, Unit& u) const {
        const long L = (long)i * G + c;
        if (L < so.nwg) return so.next(i, u);
        const int e = (int)(L - so.nwg); if (e >= 4) return false;
        u.pm = 32 + (e >> 1); u.pn = 27 + (e & 1); return true;
    }
    __device__ __forceinline__ void a_ready(const Unit&) const {}
    __device__ __forceinline__ void done(const Unit&) const {}
};
template <class Epi, class Sched, bool ALIGN_EPI = false, bool SP2 = false>
__device__ __forceinline__ void gemm_phase(PG8_LAS unsigned char* lds, const Gemm g, const Sched& S, const Epi& E) {
    const int tid = threadIdx.x, wid = __builtin_amdgcn_readfirstlane(tid >> 6), lane = tid & 63, wr = wid >> 2, wc = wid & 3, fr = lane & 15, fq = lane >> 4;
    const int K = g.K, nt = K / BK;
    unsigned voffA[2], voffB[2];
#pragma unroll
    for (int i = 0; i < 2; ++i) { int R, C; stage_rc(tid * 16 + i * 8192, R, C); const int Rb = Epi::PERM ? ((R & ~31) + perm32(R & 31)) : R;
        voffA[i] = (unsigned)(R * K + C) * 2u; voffB[i] = (unsigned)(Rb * K + C) * 2u; }
    const size_t kstep = (size_t)(BK * 2);
    const size_t hstep = (size_t)HALF * K * 2;
    const size_t tstep = 2 * hstep;
    const unsigned ldsw = (unsigned)wid * 1024u;
    const int aoff = lds_byte(wr * 64 + fr, fq * 8), boff = lds_byte(wc * 32 + fr, fq * 8);
#define PG8_SA(b, h) (((b) * 2 + (h)) * HTB)
#define PG8_SB(b, h) ((4 + (b) * 2 + (h)) * HTB)
#define PG8_STAGE(bufoff, gbase, voff) do { _Pragma("unroll") for (int _i = 0; _i < 2; ++_i) \
        __builtin_amdgcn_global_load_lds((const unsigned*)((const char*)(gbase) + (voff)[_i]), (PG8_LAS unsigned*)(lds + (bufoff) + ldsw + _i * 8192), 16, 0, 0); } while (0)
#define PG8_LDA(dst, b, h) do { _Pragma("unroll") for (int m = 0; m < 4; ++m) _Pragma("unroll") for (int k = 0; k < 2; ++k) dst[m][k] = *(const PG8_LAS bf16x8*)(lds + PG8_SA(b, h) + aoff + m * 2048 + k * 1024); } while (0)
#define PG8_LDB(dst, b, h) do { _Pragma("unroll") for (int n = 0; n < 2; ++n) _Pragma("unroll") for (int k = 0; k < 2; ++k) dst[n][k] = *(const PG8_LAS bf16x8*)(lds + PG8_SB(b, h) + boff + n * 2048 + k * 1024); } while (0)
#define PG8_MMA(ai, bj, At, Bt) do { __builtin_amdgcn_s_setprio(1); _Pragma("unroll") for (int m = 0; m < 4; ++m) _Pragma("unroll") for (int n = 0; n < 2; ++n) _Pragma("unroll") for (int k = 0; k < 2; ++k) \
        acc[ai][bj][m][n] = __builtin_amdgcn_mfma_f32_16x16x32_bf16(Bt[n][k], At[m][k], acc[ai][bj][m][n], 0, 0, 0); __builtin_amdgcn_s_setprio(0); } while (0)
#define PG8_WAIT_V(n) asm volatile("s_waitcnt vmcnt(" #n ")" ::: "memory")
#define PG8_WAIT_L(n) asm volatile("s_waitcnt lgkmcnt(" #n ")" ::: "memory")
#define PG8_BAR __builtin_amdgcn_s_barrier()
#define PG8_SCHED __builtin_amdgcn_sched_barrier(0)
    Unit cur, nxt; int ui = 0;
    if (!S.next(0, cur)) return;
    f32x4 acc[2][2][4][2];
#pragma unroll
    for (int a = 0; a < 2; ++a)
#pragma unroll
        for (int b = 0; b < 2; ++b)
#pragma unroll
            for (int m = 0; m < 4; ++m)
#pragma unroll
                for (int n = 0; n < 2; ++n) acc[a][b][m][n] = (f32x4){0.f, 0.f, 0.f, 0.f};
    bf16x8 At[4][2], B0[2][2], B1[2][2];
    const char* cA = (const char*)g.A + (size_t)cur.pm * tstep; const char* cB = (const char*)g.Bt + (size_t)cur.pn * tstep;
    S.a_ready(cur);
    if constexpr (SP2) {
        PG8_STAGE(PG8_SB(0, 0), cB, voffB); PG8_STAGE(PG8_SB(0, 1), cB + hstep, voffB); PG8_STAGE(PG8_SA(0, 0), cA, voffA); PG8_STAGE(PG8_SA(0, 1), cA + hstep, voffA);
        if (wr == 1) PG8_BAR;
        PG8_WAIT_V(2); PG8_BAR;
        PG8_STAGE(PG8_SB(1, 0), cB + kstep, voffB); PG8_STAGE(PG8_SA(1, 0), cA + kstep, voffA); PG8_STAGE(PG8_SB(1, 1), cB + hstep + kstep, voffB);
        PG8_WAIT_V(6); PG8_BAR;
    } else {
        PG8_STAGE(PG8_SB(0, 0), cB, voffB); PG8_STAGE(PG8_SA(0, 0), cA, voffA); PG8_STAGE(PG8_SB(0, 1), cB + hstep, voffB); PG8_STAGE(PG8_SA(0, 1), cA + hstep, voffA);
        if (wr == 1) PG8_BAR;
        PG8_WAIT_V(4); PG8_BAR;
        PG8_STAGE(PG8_SB(1, 0), cB + kstep, voffB); PG8_STAGE(PG8_SA(1, 0), cA + kstep, voffA); PG8_STAGE(PG8_SB(1, 1), cB + hstep + kstep, voffB);
        PG8_WAIT_V(6); PG8_BAR;
    }
    for (;;) {
        const bool has_next = S.next(ui + 1, nxt);
        const char* nA = has_next ? (const char*)g.A + (size_t)nxt.pm * tstep : cA; const char* nB = has_next ? (const char*)g.Bt + (size_t)nxt.pn * tstep : cB;
        for (int t = 0; t < nt; t += 2) {
            const bool last = (t == nt - 2);
            const char* a1 = cA + (size_t)(t + 1) * kstep;
            const char* a2 = last ? nA : cA + (size_t)(t + 2) * kstep; const char* b2 = last ? nB : cB + (size_t)(t + 2) * kstep;
            const char* a3 = a2 + kstep; const char* b3 = b2 + kstep;
            if (last && has_next) S.a_ready(nxt);
            if constexpr (SP2) {
            PG8_LDB(B0, 0, 0); PG8_LDB(B1, 0, 1); PG8_SCHED; PG8_LDA(At, 0, 0); PG8_STAGE(PG8_SA(1, 1), a1 + hstep, voffA);
            PG8_WAIT_V(8); PG8_WAIT_L(0); PG8_BAR; PG8_MMA(0, 0, At, B0); PG8_MMA(0, 1, At, B1); PG8_BAR; PG8_SCHED;
            PG8_LDA(At, 0, 1); PG8_STAGE(PG8_SB(0, 0), b2, voffB); PG8_STAGE(PG8_SB(0, 1), b2 + hstep, voffB); PG8_STAGE(PG8_SA(0, 0), a2, voffA);
            PG8_WAIT_V(8); PG8_WAIT_L(0); PG8_BAR; PG8_MMA(1, 0, At, B0); PG8_MMA(1, 1, At, B1); PG8_BAR; PG8_SCHED;
            PG8_LDB(B0, 1, 0); PG8_LDB(B1, 1, 1); PG8_SCHED; PG8_LDA(At, 1, 0); PG8_STAGE(PG8_SA(0, 1), a2 + hstep, voffA);
            PG8_WAIT_V(8); PG8_WAIT_L(0); PG8_BAR; PG8_MMA(0, 0, At, B0); PG8_MMA(0, 1, At, B1); PG8_BAR; PG8_SCHED;
            PG8_LDA(At, 1, 1); PG8_STAGE(PG8_SB(1, 0), b3, voffB); PG8_STAGE(PG8_SB(1, 1), b3 + hstep, voffB); PG8_STAGE(PG8_SA(1, 0), a3, voffA);
            PG8_WAIT_V(8); PG8_WAIT_L(0); PG8_BAR; PG8_MMA(1, 0, At, B0); PG8_MMA(1, 1, At, B1); PG8_BAR; PG8_SCHED;
            } else {
            PG8_LDB(B0, 0, 0); PG8_SCHED; PG8_LDA(At, 0, 0); PG8_STAGE(PG8_SA(1, 1), a1 + hstep, voffA);
            PG8_WAIT_L(8); PG8_BAR; PG8_WAIT_L(0); PG8_MMA(0, 0, At, B0); PG8_BAR; PG8_SCHED;
            PG8_LDB(B1, 0, 1); PG8_STAGE(PG8_SB(0, 0), b2, voffB);
            PG8_BAR; PG8_WAIT_L(0); PG8_MMA(0, 1, At, B1); PG8_BAR;
            PG8_LDA(At, 0, 1); PG8_STAGE(PG8_SA(0, 0), a2, voffA);
            PG8_BAR; PG8_WAIT_L(0); PG8_MMA(1, 0, At, B0); PG8_BAR; PG8_SCHED;
            PG8_STAGE(PG8_SB(0, 1), b2 + hstep, voffB);
            PG8_WAIT_V(6); PG8_BAR; PG8_MMA(1, 1, At, B1); PG8_BAR;
            PG8_LDB(B0, 1, 0); PG8_SCHED; PG8_LDA(At, 1, 0); PG8_STAGE(PG8_SA(0, 1), a2 + hstep, voffA);
            PG8_WAIT_L(8); PG8_BAR; PG8_WAIT_L(0); PG8_MMA(0, 0, At, B0); PG8_BAR; PG8_SCHED;
            PG8_LDB(B1, 1, 1); PG8_STAGE(PG8_SB(1, 0), b3, voffB);
            PG8_BAR; PG8_WAIT_L(0); PG8_MMA(0, 1, At, B1); PG8_BAR;
            PG8_LDA(At, 1, 1); PG8_STAGE(PG8_SA(1, 0), a3, voffA);
            PG8_BAR; PG8_WAIT_L(0); PG8_MMA(1, 0, At, B0); PG8_BAR; PG8_SCHED;
            PG8_STAGE(PG8_SB(1, 1), b3 + hstep, voffB);
            PG8_WAIT_V(6); PG8_BAR; PG8_MMA(1, 1, At, B1); PG8_BAR;
            }
        }
        if constexpr (ALIGN_EPI) { if (wr == 0) PG8_BAR; }
        if constexpr (!Epi::AFTER_DRAIN) { E(acc, cur, wr, wc, fr, fq); S.done(cur); }
        if (!has_next) break;
#pragma unroll
        for (int a = 0; a < 2; ++a)
#pragma unroll
            for (int b = 0; b < 2; ++b)
#pragma unroll
                for (int m = 0; m < 4; ++m)
#pragma unroll
                    for (int n = 0; n < 2; ++n) acc[a][b][m][n] = (f32x4){0.f, 0.f, 0.f, 0.f};
        cur = nxt; cA = nA; cB = nB; ++ui;
        if constexpr (ALIGN_EPI) { if (wr == 1) PG8_BAR; }
    }
    PG8_WAIT_V(0);
    if constexpr (!ALIGN_EPI) { if (wr == 0) PG8_BAR; }
    PG8_BAR;
    if constexpr (Epi::AFTER_DRAIN) { E.fused(acc, cur, wr, wc, fr, fq, lds, wid, lane); S.done(cur); }
#undef PG8_SA
#undef PG8_SB
#undef PG8_STAGE
#undef PG8_LDA
#undef PG8_LDB
#undef PG8_MMA
#undef PG8_WAIT_V
#undef PG8_WAIT_L
#undef PG8_BAR
#undef PG8_SCHED
}
}

#ifndef PG8_SP2
#define PG8_SP2 true
#endif
#ifndef PG8_ALIGN
#define PG8_ALIGN true
#endif

#define GAS __attribute__((address_space(1)))
#define LAS __attribute__((address_space(3)))
typedef unsigned v4u __attribute__((ext_vector_type(4)));
typedef float f32x4 __attribute__((ext_vector_type(4)));
typedef short bf16x8 __attribute__((ext_vector_type(8)));
typedef GAS unsigned gu32;
typedef GAS unsigned long long gu64;
#define RLX_AGENT __ATOMIC_RELAXED, __HIP_MEMORY_SCOPE_AGENT
#define LDS_WAIT() asm volatile("s_waitcnt lgkmcnt(0)" ::: "memory")
#define VM_WAIT() asm volatile("s_waitcnt vmcnt(0)" ::: "memory")

#define XB_TMO      128
#define XB_XCNT(j)  (256  + 64 * (j))
#define XB_XSUB(j)  (1280 + 64 * (j))
#define XB_XGEN(j)  (2304 + 64 * (j))
#define XB_TOP      3328
#define XB_TOPGEN   3392
#define XCD_BAR_WORDS 3456
#define XB_SPIN_CAP (1u << 18)

__device__ __forceinline__ unsigned xb_ld(unsigned* p)              { return __hip_atomic_load(p, __ATOMIC_RELAXED, __HIP_MEMORY_SCOPE_AGENT); }
__device__ __forceinline__ unsigned xb_add(unsigned* p, unsigned v) { return __hip_atomic_fetch_add(p, v, __ATOMIC_RELAXED, __HIP_MEMORY_SCOPE_AGENT); }
__device__ __forceinline__ unsigned xb_xcc_id() { return (unsigned)__builtin_amdgcn_s_getreg((3 << 11) | 20) & 0xFu; }
#define XB_SPIN(cond, bar) do { unsigned _sp = 0; while (cond) { __builtin_amdgcn_s_sleep(1); \
    if ((++_sp & 255u) == 0u) { if (xb_ld(&(bar)[XB_TMO])) break; if (_sp > XB_SPIN_CAP) { atomicAdd(&(bar)[XB_TMO], 1u); break; } } } } while (0)

struct XcdBarrier {
    unsigned* bar; unsigned x;
    volatile LAS unsigned* st;
};

__device__ __forceinline__ XcdBarrier xcd_barrier_post(unsigned* bar, volatile LAS unsigned* st) {
    XcdBarrier b; b.bar = bar; b.x = xb_xcc_id(); b.st = st;
    if (threadIdx.x == 0) (void)xb_add(&bar[XB_XCNT(b.x)], 1u);
    return b;
}
__device__ __forceinline__ void xcd_barrier_complete(unsigned* bar, unsigned x, unsigned& nloc, unsigned& nx) {
    const unsigned G = gridDim.x * gridDim.y * gridDim.z;
    unsigned sum, cnt, mine, sp = 0u;
    for (;;) {
        sum = 0u; cnt = 0u; mine = 0u;
#pragma unroll
        for (unsigned j = 0; j < 16; ++j) { const unsigned c = xb_ld(&bar[XB_XCNT(j)]); sum += c; cnt += (c > 0u) ? 1u : 0u; mine = (j == x) ? c : mine; }
        if (sum == G) break;
        __builtin_amdgcn_s_sleep(1);
        if ((++sp & 255u) == 0u) { if (xb_ld(&bar[XB_TMO])) break; if (sp > XB_SPIN_CAP) { atomicAdd(&bar[XB_TMO], 1u); break; } }
    }
    nloc = mine > 0u ? mine : 1u; nx = cnt > 0u ? cnt : 1u;
}

__device__ __forceinline__ void xcd_barrier(const XcdBarrier& b) {
    asm volatile("s_waitcnt vmcnt(0)" ::: "memory");
    __syncthreads();
    if (threadIdx.x == 0) {
        unsigned* bar = b.bar;
        __builtin_amdgcn_s_waitcnt(0);
        unsigned nloc = b.st[0], nx = b.st[1];
        if (nloc == 0u) { xcd_barrier_complete(bar, b.x, nloc, nx); b.st[0] = nloc; b.st[1] = nx; }
        const unsigned old = xb_add(&bar[XB_XSUB(b.x)], 1u);
        const unsigned gen = old / nloc;
        if (old + 1u == (gen + 1u) * nloc) {
            __builtin_amdgcn_fence(__ATOMIC_RELEASE, "agent");
            asm volatile("s_waitcnt vmcnt(0)" ::: "memory");
            const unsigned og = xb_add(&bar[XB_TOP], 1u);
            const unsigned tg = og / nx;
            if (og + 1u == (tg + 1u) * nx) xb_add(&bar[XB_TOPGEN], 1u);
            else XB_SPIN(xb_ld(&bar[XB_TOPGEN]) == tg, bar);
            __builtin_amdgcn_fence(__ATOMIC_ACQUIRE, "agent");
            xb_add(&bar[XB_XGEN(b.x)], 1u);
            asm volatile("s_waitcnt vmcnt(0)" ::: "memory");
        } else {
            XB_SPIN(xb_ld(&bar[XB_XGEN(b.x)]) == gen, bar);
            __builtin_amdgcn_fence(__ATOMIC_ACQUIRE, "agent");
            asm volatile("s_waitcnt vmcnt(0)" ::: "memory");
        }
    }
    __syncthreads();
}

#ifndef STEP
#define STEP 3
#endif
#ifndef REP_PHASE
#define REP_PHASE -1
#endif
#ifndef PREFIX_K
#define PREFIX_K 0
#endif
#ifndef ONE_LAUNCH
#define ONE_LAUNCH 1
#endif
constexpr int NWAVES = 8;
constexpr int LDS_BYTES = 147456;
constexpr int RING_OFF = 0, RING_BYTES = 131072;
constexpr int MISC_OFF = RING_BYTES + 320;
constexpr int CW_BAR = 4096;
constexpr size_t CTL_ZERO_BYTES = 64 * 1024;

struct Frame {
    LAS unsigned char* lds;
    volatile LAS unsigned* MISC;
    int tid, lane, wave, vcu, G;
};

__device__ __forceinline__ float wave_sum(float v) {
#pragma unroll
    for (int o = 1; o < 64; o <<= 1) v += __shfl_xor(v, o);
    return v;
}
__device__ __forceinline__ unsigned pk2(float lo, float hi) { return f2bf(lo) | (f2bf(hi) << 16); }

__device__ __forceinline__ void p0_transpose_item(const float* __restrict__ W, int K, int Nsrc, int n_src0, bf16_t* __restrict__ WT, int n_dst0, const float* __restrict__ kw,
                                                  LAS float* scr, int kb, int nb, int lane, int ncols_valid) {
    const int k0 = 64 * kb, n0 = 32 * nb;
#pragma unroll 8
    for (int i = 0; i < 32; ++i) { const int kk = 2 * i + (lane >> 5); const int nn = lane & 31;
        float v = 0.f; if (nn < ncols_valid) { v = W[(size_t)(k0 + kk) * Nsrc + n_src0 + n0 + nn]; if (kw) v *= kw[k0 + kk]; }
        scr[kk * 33 + nn] = v; }
    LDS_WAIT(); asm volatile("" ::: "memory");
    const int c = lane & 7;
#pragma unroll
    for (int j = 0; j < 4; ++j) { const int n = (lane >> 3) + 8 * j; const LAS float* s = scr + (8 * c) * 33 + n;
        v4u o; o.x = pk2(s[0 * 33], s[1 * 33]); o.y = pk2(s[2 * 33], s[3 * 33]); o.z = pk2(s[4 * 33], s[5 * 33]); o.w = pk2(s[6 * 33], s[7 * 33]);
        *(GAS v4u*)(WT + (size_t)(n_dst0 + n0 + n) * K + k0 + 8 * c) = o; }
    LDS_WAIT(); asm volatile("" ::: "memory");
}
__device__ __forceinline__ void row_to_bf16(const float* xrow, bf16_t* orow, float* rstd_out, int lane) {
    const GAS f32x4* xr = (const GAS f32x4*)xrow + lane;
    f32x4 v[8]; float s = 0.f;
#pragma unroll
    for (int j = 0; j < 8; ++j) { v[j] = xr[64 * j]; s += (v[j].x * v[j].x + v[j].y * v[j].y) + (v[j].z * v[j].z + v[j].w * v[j].w); }
    s = wave_sum(s);
    GAS unsigned long long* o8 = (GAS unsigned long long*)orow + lane;
#pragma unroll
    for (int j = 0; j < 8; ++j) o8[64 * j] = (unsigned long long)pk2(v[j].x, v[j].y) | ((unsigned long long)pk2(v[j].z, v[j].w) << 32);
    if (lane == 0) *rstd_out = 1.0f / sqrtf(s * (1.f / DM) + EPS);
}


typedef float f32x16 __attribute__((ext_vector_type(16)));
typedef short s16x4 __attribute__((ext_vector_type(4)));
typedef short v4i16_t __attribute__((ext_vector_type(4)));
__device__ __forceinline__ int crow(int r, int h) { return (r & 3) + 8 * (r >> 2) + 4 * h; }
__device__ __forceinline__ unsigned cvtpk(float lo, float hi) { typedef float f2 __attribute__((ext_vector_type(2))); typedef __bf16 b2 __attribute__((ext_vector_type(2)));
    f2 v = {lo, hi}; b2 b = __builtin_convertvector(v, b2); return __builtin_bit_cast(unsigned, b); }
__device__ __forceinline__ bf16x8 frag_row(const LAS unsigned char* tile, int pitch, int row0, int kbyte0, int lane) {
    return *(const LAS bf16x8*)(tile + (row0 + (lane & 31)) * pitch + kbyte0 + 16 * (lane >> 5));
}
__device__ __forceinline__ bf16x8 frag_tr(const LAS unsigned char* tile, int pitch, int kb_lo, int kb_step, int col0, int lane) {
    const LAS unsigned char* p = tile + (kb_lo + ((lane & 15) >> 2)) * pitch + (col0 + 16 * ((lane >> 4) & 1) + 4 * (lane & 3)) * 2;
    const s16x4 lo = __builtin_bit_cast(s16x4, __builtin_amdgcn_ds_read_tr16_b64_v4i16((LAS v4i16_t*)p));
    const s16x4 hi = __builtin_bit_cast(s16x4, __builtin_amdgcn_ds_read_tr16_b64_v4i16((LAS v4i16_t*)(p + kb_step * pitch)));
    return (bf16x8){lo[0], lo[1], lo[2], lo[3], hi[0], hi[1], hi[2], hi[3]};
}
__device__ __forceinline__ bf16x8 acc_frag(const f32x16& X, int s) {
    v4u w; w.x = cvtpk(X[8 * s + 0], X[8 * s + 1]); w.y = cvtpk(X[8 * s + 2], X[8 * s + 3]); w.z = cvtpk(X[8 * s + 4], X[8 * s + 5]); w.w = cvtpk(X[8 * s + 6], X[8 * s + 7]);
    return __builtin_bit_cast(bf16x8, w);
}
#define MFMA32(a, b, c) __builtin_amdgcn_mfma_f32_32x32x16_bf16((a), (b), (c), 0, 0, 0)

constexpr int KPITCH = 144, VPITCH = 192;
constexpr float LOG2E = 1.4426950408889634f;

template <int NT, bool DIL>
__device__ __forceinline__ void attn_wave(const LAS unsigned char* Kt, const LAS unsigned char* Vt, int krow0, const bf16x8 (&qf)[4], const LAS float* Tb, int kt0, int lane,
                                          f32x16 (&o)[2], float& m_out, float& l_out) {
    const int q = lane & 31, h = lane >> 5;
    f32x16 X[NT];
    float m = -1e30f;
    const LAS float* tb = Tb + (q - 4 * h);
#pragma unroll
    for (int kt = 0; kt < NT; ++kt) {
        X[kt] = (f32x16){};
        if (!DIL || kt >= kt0) {
#pragma unroll
            for (int d0 = 0; d0 < 4; ++d0) X[kt] = MFMA32(frag_row(Kt, KPITCH, krow0 + 32 * kt, 32 * d0, lane), qf[d0], X[kt]);
#pragma unroll
            for (int r = 0; r < 16; ++r) {
                if (DIL) X[kt][r] += tb[128 - 32 * kt - (r & 3) - 8 * (r >> 2)];
                m = fmaxf(m, X[kt][r]);
            }
        }
    }
    m = fmaxf(m, __shfl_xor(m, 32));
    float l = 0.f; o[0] = (f32x16){}; o[1] = (f32x16){};
#pragma unroll
    for (int kt = 0; kt < NT; ++kt) {
        if (!DIL || kt >= kt0) {
#pragma unroll
            for (int r = 0; r < 16; ++r) { const float p = __builtin_amdgcn_exp2f(X[kt][r] - m); l += p; X[kt][r] = p; }
#pragma unroll
            for (int s2 = 0; s2 < 2; ++s2) { const bf16x8 pf = acc_frag(X[kt], s2);
#pragma unroll
                for (int db = 0; db < 2; ++db) o[db] = MFMA32(frag_tr(Vt, VPITCH, krow0 + 32 * kt + 16 * s2 + 4 * h, 8, 32 * db, lane), pf, o[db]); }
        }
    }
    l += __shfl_xor(l, 32);
    m_out = m; l_out = l;
}

template <int PITCH, class RowFn>
__device__ __forceinline__ void stage_rows(LAS unsigned char* T, const bf16_t* g, int gpitch, int nrows, int tid, RowFn grow) {
    for (int i = tid; i < nrows * 8; i += NWAVES * 64) { const int row = i >> 3, ch = i & 7; const long gr = grow(row);
        v4u kv = {0u, 0u, 0u, 0u};
        if (gr >= 0) kv = *(const GAS v4u*)(g + (size_t)gr * gpitch + ch * 8);
        *(LAS v4u*)(T + row * PITCH + ch * 16) = kv; }
}

constexpr int ATT_K_OFF = 0, ATT_V_OFF = 384 * KPITCH, ATT_T_OFF = ATT_V_OFF + 384 * VPITCH;
constexpr int N_DIL_UNITS = 3 * 2 * 12 * 16, N_MEM_UNITS = 2 * 4 * 16;

__device__ __forceinline__ void dil_attn_unit(Frame& F, unsigned char* ws, int u) {
    const int j = u & 15, hd = (u >> 4) % 12, b = ((u >> 4) / 12) & 1, p = (u >> 4) / 24;
    const int dil = p == 0 ? 1 : (p == 1 ? 4 : 16), nblk = 16 / dil;
    const int cls = j / nblk, blk = j % nblk, l0 = blk * 256;
    LAS unsigned char* Kt = F.lds + ATT_K_OFF; LAS unsigned char* Vt = F.lds + ATT_V_OFF; LAS float* Tb = (LAS float*)(F.lds + ATT_T_OFF);
    const bf16_t* gQ = (const bf16_t*)(ws + WS_DQ) + hd * 64; const bf16_t* gK = (const bf16_t*)(ws + WS_DK) + hd * 64; const bf16_t* gV = (const bf16_t*)(ws + WS_DV) + hd * 64;
    const long rowb = (long)b * SEQ;
    auto grow = [&](int row) -> long { const int ls = l0 - 128 + row; return ls < 0 ? -1L : rowb + (long)ls * dil + cls; };
    stage_rows<KPITCH>(Kt, gK, 768, 384, F.tid, grow);
    stage_rows<VPITCH>(Vt, gV, 768, 384, F.tid, grow);
    if (F.tid < 192) { const int d = F.tid - 32; Tb[F.tid] = (d >= 0 && d <= 128) ? ((const float*)(ws + WS_BIAS))[(p * 12 + hd) * 132 + d] * LOG2E : -1e30f; }
    const int q = F.lane & 31, h = F.lane >> 5;
    const int qsub0 = l0 + 32 * F.wave;
    const long mrow = rowb + (long)(qsub0 + q) * dil + cls;
    bf16x8 qf[4];
#pragma unroll
    for (int d0 = 0; d0 < 4; ++d0) qf[d0] = *(const GAS bf16x8*)(gQ + (size_t)mrow * 768 + 16 * d0 + 8 * h);
    __syncthreads();
    f32x16 o[2]; float m, l;
    const int kt0 = (blk == 0 && F.wave < 4) ? 4 - F.wave : 0;
    attn_wave<5, true>(Kt, Vt, 32 * F.wave, qf, Tb + 32, kt0, F.lane, o, m, l);
    const float inv = 1.f / l;
    bf16_t* O = (bf16_t*)(ws + WS_OP) + (size_t)p * M * 768 + (size_t)mrow * 768 + hd * 64;
#pragma unroll
    for (int db = 0; db < 2; ++db)
#pragma unroll
        for (int g = 0; g < 4; ++g) { const unsigned w0 = cvtpk(o[db][4 * g] * inv, o[db][4 * g + 1] * inv), w1 = cvtpk(o[db][4 * g + 2] * inv, o[db][4 * g + 3] * inv);
            *(GAS unsigned long long*)(O + 32 * db + 8 * g + 4 * h) = (unsigned long long)w0 | ((unsigned long long)w1 << 32); }
    if (h == 0) ((float*)(ws + WS_LSE))[((size_t)p * M + mrow) * 12 + hd] = (m + __builtin_amdgcn_logf(l)) * 0.6931471805599453f;
    __syncthreads();
}

__device__ __forceinline__ void mem_attn_unit(Frame& F, unsigned char* ws, int u) {
    const int blk = u & 15, hm = (u >> 4) & 3, b = u >> 6;
    LAS unsigned char* Kt = F.lds + ATT_K_OFF; LAS unsigned char* Vt = F.lds + ATT_V_OFF;
    const bf16_t* gQ = (const bf16_t*)(ws + WS_MQ) + hm * 64; const bf16_t* gK = (const bf16_t*)(ws + WS_MK) + hm * 64; const bf16_t* gV = (const bf16_t*)(ws + WS_MV) + hm * 64;
    auto grow = [&](int row) -> long { return (long)b * MEML + row; };
    stage_rows<KPITCH>(Kt, gK, 256, 256, F.tid, grow);
    stage_rows<VPITCH>(Vt, gV, 256, 256, F.tid, grow);
    const int q = F.lane & 31, h = F.lane >> 5;
    const long mrow = (long)b * SEQ + blk * 256 + 32 * F.wave + q;
    bf16x8 qf[4];
#pragma unroll
    for (int d0 = 0; d0 < 4; ++d0) qf[d0] = *(const GAS bf16x8*)(gQ + (size_t)mrow * 256 + 16 * d0 + 8 * h);
    __syncthreads();
    f32x16 o[2]; float m, l;
    attn_wave<8, false>(Kt, Vt, 0, qf, nullptr, 0, F.lane, o, m, l);
    const float inv = 1.f / l;
    const bf16_t* SG = (const bf16_t*)(ws + WS_SG) + (size_t)mrow * 2048 + 1792 + hm * 64; bf16_t* O = (bf16_t*)(ws + WS_MIXG) + (size_t)mrow * 2048 + 1792 + hm * 64;
#pragma unroll
    for (int db = 0; db < 2; ++db)
#pragma unroll
        for (int g = 0; g < 4; ++g) { const int c = 32 * db + 8 * g + 4 * h; const unsigned long long sg = *(const GAS unsigned long long*)(SG + c);
            const float g0 = bf2f((unsigned short)sg), g1 = bf2f((unsigned short)(sg >> 16)), g2 = bf2f((unsigned short)(sg >> 32)), g3 = bf2f((unsigned short)(sg >> 48));
            const unsigned w0 = cvtpk(o[db][4 * g] * inv * g0, o[db][4 * g + 1] * inv * g1), w1 = cvtpk(o[db][4 * g + 2] * inv * g2, o[db][4 * g + 3] * inv * g3);
            *(GAS unsigned long long*)(O + c) = (unsigned long long)w0 | ((unsigned long long)w1 << 32); }
    __syncthreads();
}

constexpr int GQT_PITCH = 272, GKS_PITCH = 320, GV_PITCH = 576, GOT_PITCH = 1040;
constexpr int N_GLA_UNITS = 8 * 64;
__device__ __forceinline__ void gla_a_unit(Frame& F, unsigned char* ws, const float* __restrict__ w2, const float* __restrict__ bg, int u) {
    const int n = u & 63, bh = u >> 6, b = bh >> 2, hg = bh & 3;
    const size_t m0 = (size_t)b * SEQ + 64 * n;
    LAS float* GL = (LAS float*)(F.lds);
    LAS float* GS = (LAS float*)(F.lds + 4096);
    LAS unsigned char* KS = F.lds + 8192;
    LAS unsigned char* VT = F.lds + 8192 + 64 * GKS_PITCH;
    LAS unsigned char* LT = F.lds + 8192;
    const bf16_t* GQ = (const bf16_t*)(ws + WS_GQ); const bf16_t* GK = (const bf16_t*)(ws + WS_GK); const bf16_t* GV = (const bf16_t*)(ws + WS_GV);
    bf16_t* QTg = (bf16_t*)(ws + WS_QT); bf16_t* KTg = (bf16_t*)(ws + WS_KT);
    const int c2 = F.lane, tg = F.wave;
    unsigned qk[8], kk[8];
#pragma unroll
    for (int tt = 0; tt < 8; ++tt) { const size_t gi = (m0 + 8 * tg + tt) * 512 + hg * 128 + 2 * c2; qk[tt] = *(const GAS unsigned*)(GQ + gi); kk[tt] = *(const GAS unsigned*)(GK + gi); }
    if (F.tid < 256) *(LAS f32x4*)(GL + 4 * F.tid) = *(const GAS f32x4*)((const float*)(ws + WS_GLR) + m0 * 16 + 4 * F.tid);
    for (int i = F.tid; i < 64 * 32; i += NWAVES * 64) { const int row = i >> 5, ch = i & 31;
        *(LAS v4u*)(VT + row * GV_PITCH + ch * 16) = *(const GAS v4u*)(GV + (m0 + row) * 1024 + hg * 256 + ch * 8); }
    float w0[16], w1[16];
#pragma unroll
    for (int jj = 0; jj < 16; ++jj) { typedef float f2 __attribute__((ext_vector_type(2))); const f2 w = *(const GAS f2*)(w2 + jj * 512 + hg * 128 + 2 * c2); w0[jj] = w[0]; w1[jj] = w[1]; }
    const float bg0 = bg[hg * 128 + 2 * c2], bg1 = bg[hg * 128 + 2 * c2 + 1];
    __syncthreads();
    float b0[8], b1[8]; float cum0 = 0.f, cum1 = 0.f;
#pragma unroll
    for (int tt = 0; tt < 8; ++tt) { const int t = tg * 8 + tt; float z0 = bg0, z1 = bg1;
#pragma unroll
        for (int j4 = 0; j4 < 4; ++j4) { const f32x4 g = *(const LAS f32x4*)(GL + t * 16 + 4 * j4);
#pragma unroll
            for (int e = 0; e < 4; ++e) { z0 += g[e] * w0[4 * j4 + e]; z1 += g[e] * w1[4 * j4 + e]; } }
        const float ls0 = fminf(z0, 0.f) - log1pf(__expf(-fabsf(z0))), ls1 = fminf(z1, 0.f) - log1pf(__expf(-fabsf(z1)));
        cum0 += ls0 * (1.f / 16.f); cum1 += ls1 * (1.f / 16.f); b0[tt] = cum0; b1[tt] = cum1; }
    { typedef float f2 __attribute__((ext_vector_type(2))); *(LAS f2*)(GS + tg * 128 + 2 * c2) = (f2){cum0, cum1}; }
    __syncthreads();
    float off0 = 0.f, off1 = 0.f, bl0 = 0.f, bl1 = 0.f;
#pragma unroll
    for (int g = 0; g < 8; ++g) { typedef float f2 __attribute__((ext_vector_type(2))); const f2 sgv = *(const LAS f2*)(GS + g * 128 + 2 * c2); bl0 += sgv[0]; bl1 += sgv[1]; if (g < tg) { off0 += sgv[0]; off1 += sgv[1]; } }
#pragma unroll
    for (int tt = 0; tt < 8; ++tt) { const int t = tg * 8 + tt; const float bt0 = off0 + b0[tt], bt1 = off1 + b1[tt]; const size_t gi = (m0 + t) * 512 + hg * 128 + 2 * c2;
        const float q0 = bf2f((unsigned short)qk[tt]), q1 = bf2f((unsigned short)(qk[tt] >> 16)), k0 = bf2f((unsigned short)kk[tt]), k1 = bf2f((unsigned short)(kk[tt] >> 16));
        *(GAS unsigned*)(QTg + gi) = pk2(q0 * __expf(bt0), q1 * __expf(bt1));
        *(GAS unsigned*)(KTg + gi) = pk2(k0 * __expf(-bt0), k1 * __expf(-bt1));
        *(LAS unsigned*)(KS + t * GKS_PITCH + c2 * 4) = pk2(k0 * __expf(bl0 - bt0), k1 * __expf(bl1 - bt1)); }
    if (tg == 0) { typedef float f2 __attribute__((ext_vector_type(2))); *(GAS f2*)((float*)(ws + WS_DEC) + (size_t)u * 128 + 2 * c2) = (f2){__expf(bl0), __expf(bl1)}; }
    __syncthreads();
    const int h = F.lane >> 5;
    f32x16 acc[4] = {};
#pragma unroll
    for (int s = 0; s < 4; ++s) { const bf16x8 bv = frag_tr(VT, GV_PITCH, 16 * s + 8 * h, 4, 32 * F.wave, F.lane);
#pragma unroll
        for (int cb = 0; cb < 4; ++cb) acc[cb] = MFMA32(frag_tr(KS, GKS_PITCH, 16 * s + 8 * h, 4, 32 * cb, F.lane), bv, acc[cb]); }
    __syncthreads();
    { const int v = 32 * F.wave + (F.lane & 31);
#pragma unroll
      for (int cb = 0; cb < 4; ++cb)
#pragma unroll
        for (int g = 0; g < 4; ++g) { const unsigned lo = cvtpk(acc[cb][4 * g], acc[cb][4 * g + 1]), hi2 = cvtpk(acc[cb][4 * g + 2], acc[cb][4 * g + 3]);
            *(LAS unsigned long long*)(LT + v * 272 + (32 * cb + 8 * g + 4 * h) * 2) = (unsigned long long)lo | ((unsigned long long)hi2 << 32); } }
    __syncthreads();
    bf16_t* KV = (bf16_t*)(ws + WS_KV) + (size_t)u * 256 * 128;
    for (int i = F.tid; i < 256 * 16; i += NWAVES * 64) { const int row = i >> 4, ch = i & 15; *(GAS v4u*)(KV + (size_t)row * 128 + ch * 8) = *(const LAS v4u*)(LT + row * 272 + ch * 16); }
    __syncthreads();
}
__device__ __forceinline__ void gla_scan_item(unsigned char* ws, int i) {
    const int c8 = i & 15, v = (i >> 4) & 255, bh = i >> 12;
    bf16_t* KV = (bf16_t*)(ws + WS_KV) + ((size_t)bh * 64 * 256 + v) * 128 + 8 * c8;
    const float* DEC = (const float*)(ws + WS_DEC) + (size_t)bh * 64 * 128 + 8 * c8;
    float S[8] = {};
#pragma unroll 4
    for (int n = 0; n < 63; ++n) {
        const v4u kv = *(const GAS v4u*)(KV + (size_t)n * 256 * 128);
        const f32x4 d0 = *(const GAS f32x4*)(DEC + n * 128), d1 = *(const GAS f32x4*)(DEC + n * 128 + 4);
        S[0] = d0[0] * S[0] + bf2f((unsigned short)kv.x); S[1] = d0[1] * S[1] + bf2f((unsigned short)(kv.x >> 16));
        S[2] = d0[2] * S[2] + bf2f((unsigned short)kv.y); S[3] = d0[3] * S[3] + bf2f((unsigned short)(kv.y >> 16));
        S[4] = d1[0] * S[4] + bf2f((unsigned short)kv.z); S[5] = d1[1] * S[5] + bf2f((unsigned short)(kv.z >> 16));
        S[6] = d1[2] * S[6] + bf2f((unsigned short)kv.w); S[7] = d1[3] * S[7] + bf2f((unsigned short)(kv.w >> 16));
        v4u o; o.x = pk2(S[0], S[1]); o.y = pk2(S[2], S[3]); o.z = pk2(S[4], S[5]); o.w = pk2(S[6], S[7]);
        *(GAS v4u*)(KV + (size_t)n * 256 * 128) = o;
    }
}
__device__ __forceinline__ void gla_c_unit(Frame& F, unsigned char* ws, const float* __restrict__ gnw, int u) {
    const int n = u & 63, bh = u >> 6, b = bh >> 2, hg = bh & 3;
    const size_t m0 = (size_t)b * SEQ + 64 * n;
    LAS unsigned char* QT = F.lds; LAS unsigned char* KT = F.lds + 64 * GQT_PITCH; LAS unsigned char* VT = F.lds + 128 * GQT_PITCH;
    LAS float* RED = (LAS float*)(F.lds + 128 * GQT_PITCH + 64 * GV_PITCH);
    LAS unsigned char* OT = F.lds;
    const bf16_t* GQ = (const bf16_t*)(ws + WS_QT); const bf16_t* GK = (const bf16_t*)(ws + WS_KT); const bf16_t* GV = (const bf16_t*)(ws + WS_GV);
    for (int i = F.tid; i < 64 * 16; i += NWAVES * 64) { const int row = i >> 4, ch = i & 15; const size_t gi = (m0 + row) * 512 + hg * 128 + ch * 8;
        *(LAS v4u*)(QT + row * GQT_PITCH + ch * 16) = *(const GAS v4u*)(GQ + gi); *(LAS v4u*)(KT + row * GQT_PITCH + ch * 16) = *(const GAS v4u*)(GK + gi); }
    for (int i = F.tid; i < 64 * 32; i += NWAVES * 64) { const int row = i >> 5, ch = i & 31;
        *(LAS v4u*)(VT + row * GV_PITCH + ch * 16) = *(const GAS v4u*)(GV + (m0 + row) * 1024 + hg * 256 + ch * 8); }
    __syncthreads();
    const int q = F.lane & 31, h = F.lane >> 5, tb = F.wave & 1, vs = F.wave >> 1;
    f32x16 X[2] = {};
#pragma unroll
    for (int kt = 0; kt < 2; ++kt) if (kt <= tb) {
#pragma unroll
        for (int s = 0; s < 8; ++s) X[kt] = MFMA32(frag_row(KT, GQT_PITCH, 32 * kt, 32 * s, F.lane), frag_row(QT, GQT_PITCH, 32 * tb, 32 * s, F.lane), X[kt]);
        if (kt == tb) {
#pragma unroll
            for (int r = 0; r < 16; ++r) if (crow(r, h) > q) X[kt][r] = 0.f;
        }
    }
    f32x16 o[2] = {};
    const bf16_t* SN = (const bf16_t*)(ws + WS_KV) + (size_t)(u - 1) * 256 * 128;
#pragma unroll
    for (int vb = 0; vb < 2; ++vb) { const int V = 2 * vs + vb;
#pragma unroll
        for (int kt = 0; kt < 2; ++kt) if (kt <= tb) {
#pragma unroll
            for (int s2 = 0; s2 < 2; ++s2) o[vb] = MFMA32(frag_tr(VT, GV_PITCH, 32 * kt + 16 * s2 + 4 * h, 8, 32 * V, F.lane), acc_frag(X[kt], s2), o[vb]); }
        if (n > 0) {
#pragma unroll
            for (int s = 0; s < 8; ++s) { const bf16x8 a = *(const GAS bf16x8*)(SN + (size_t)(32 * V + q) * 128 + 16 * s + 8 * h);
                o[vb] = MFMA32(a, frag_row(QT, GQT_PITCH, 32 * tb, 32 * s, F.lane), o[vb]); } }
    }
    float ss = 0.f;
#pragma unroll
    for (int vb = 0; vb < 2; ++vb)
#pragma unroll
        for (int r = 0; r < 16; ++r) ss += o[vb][r] * o[vb][r];
    ss += __shfl_xor(ss, 32);
    if (h == 0) RED[vs * 64 + 32 * tb + q] = ss;
    __syncthreads();
    const int tok = 32 * tb + q;
    const float tot = RED[tok] + RED[64 + tok] + RED[128 + tok] + RED[192 + tok];
    const float rstd = 1.0f / sqrtf(tot * (1.f / 256.f) + EPS);
#pragma unroll
    for (int vb = 0; vb < 2; ++vb)
#pragma unroll
        for (int g = 0; g < 4; ++g) { const int v0 = 32 * (2 * vs + vb) + 8 * g + 4 * h; const f32x4 w = *(const GAS f32x4*)(gnw + v0);
            f32x4 val; val[0] = o[vb][4 * g] * rstd * w[0]; val[1] = o[vb][4 * g + 1] * rstd * w[1]; val[2] = o[vb][4 * g + 2] * rstd * w[2]; val[3] = o[vb][4 * g + 3] * rstd * w[3];
            *(LAS f32x4*)(OT + tok * GOT_PITCH + v0 * 4) = val; }
    __syncthreads();
    for (int i = F.tid; i < 64 * 32; i += NWAVES * 64) { const int row = i >> 5, ch = i & 31; const size_t gi = (m0 + row) * 2048 + 768 + hg * 256 + ch * 8;
        const f32x4 a = *(const LAS f32x4*)(OT + row * GOT_PITCH + ch * 32), bq = *(const LAS f32x4*)(OT + row * GOT_PITCH + ch * 32 + 16);
        const v4u sg = *(const GAS v4u*)((const bf16_t*)(ws + WS_SG) + gi);
        v4u w; w.x = pk2(a[0] * bf2f((unsigned short)sg.x), a[1] * bf2f((unsigned short)(sg.x >> 16))); w.y = pk2(a[2] * bf2f((unsigned short)sg.y), a[3] * bf2f((unsigned short)(sg.y >> 16)));
        w.z = pk2(bq[0] * bf2f((unsigned short)sg.z), bq[1] * bf2f((unsigned short)(sg.z >> 16))); w.w = pk2(bq[2] * bf2f((unsigned short)sg.w), bq[3] * bf2f((unsigned short)(sg.w >> 16)));
        *(GAS v4u*)((bf16_t*)(ws + WS_MIXG) + gi) = w; }
    __syncthreads();
}

__device__ __forceinline__ void dil_combine_item(unsigned char* ws, int i) {
    const int c8 = i % 96, m = i / 96, hd = c8 >> 3;
    const float* LSE = (const float*)(ws + WS_LSE);
    const float l0 = LSE[((size_t)0 * M + m) * 12 + hd], l1 = LSE[((size_t)1 * M + m) * 12 + hd], l2 = LSE[((size_t)2 * M + m) * 12 + hd];
    const float mx = fmaxf(l0, fmaxf(l1, l2));
    float w0 = __expf(l0 - mx), w1 = __expf(l1 - mx), w2 = __expf(l2 - mx); const float inv = 1.f / (w0 + w1 + w2); w0 *= inv; w1 *= inv; w2 *= inv;
    const bf16_t* OP = (const bf16_t*)(ws + WS_OP) + (size_t)m * 768 + c8 * 8;
    const v4u a = *(const GAS v4u*)OP, bb = *(const GAS v4u*)(OP + (size_t)M * 768), cc = *(const GAS v4u*)(OP + (size_t)2 * M * 768);
    const v4u sg = *(const GAS v4u*)((const bf16_t*)(ws + WS_SG) + (size_t)m * 2048 + c8 * 8);
    v4u o;
#define CMB(f) { const float lo = (w0 * bf2f((unsigned short)a.f) + w1 * bf2f((unsigned short)bb.f) + w2 * bf2f((unsigned short)cc.f)) * bf2f((unsigned short)sg.f); \
                 const float hi = (w0 * bf2f((unsigned short)(a.f >> 16)) + w1 * bf2f((unsigned short)(bb.f >> 16)) + w2 * bf2f((unsigned short)(cc.f >> 16))) * bf2f((unsigned short)(sg.f >> 16)); o.f = pk2(lo, hi); }
    CMB(x) CMB(y) CMB(z) CMB(w)
#undef CMB
    *(GAS v4u*)((bf16_t*)(ws + WS_MIXG) + (size_t)m * 2048 + c8 * 8) = o;
}
__device__ __forceinline__ void final_row(const float* xrow, const float* yrow, const float* w, float* orow, int lane) {
    const GAS f32x4* yr = (const GAS f32x4*)yrow + lane; const GAS f32x4* xr = (const GAS f32x4*)xrow + lane; const GAS f32x4* wr = (const GAS f32x4*)w + lane;
    f32x4 v[8]; float s = 0.f;
#pragma unroll
    for (int j = 0; j < 8; ++j) { v[j] = yr[64 * j]; s += (v[j].x * v[j].x + v[j].y * v[j].y) + (v[j].z * v[j].z + v[j].w * v[j].w); }
    s = wave_sum(s);
    const float r = 1.0f / sqrtf(s * (1.f / DM) + EPS);
    GAS f32x4* o = (GAS f32x4*)orow + lane;
#pragma unroll
    for (int j = 0; j < 8; ++j) o[64 * j] = xr[64 * j] + v[j] * r * wr[64 * j];
}
struct Args { const float* in[12]; float* out; unsigned char* ws; int ph_lo, ph_hi; };

__device__ __forceinline__ void p0_prologue(Frame& F, const Args& a) {
    LAS float* scr = (LAS float*)(F.lds + RING_OFF + F.wave * 16384);
    const int gw = F.vcu * NWAVES + F.wave, NGW = F.G * NWAVES;
    unsigned char* ws = a.ws;
    bf16_t* WinT = (bf16_t*)(ws + WS_WIN); bf16_t* WoutT = (bf16_t*)(ws + WS_WOUT); bf16_t* WmemT = (bf16_t*)(ws + WS_WMEM);
    const float* w_in = a.in[3]; const float* npre = a.in[2]; const float* wmem = a.in[9]; const float* mnw = a.in[8]; const float* wout = a.in[10];
    constexpr int KB = DM / 64;
    constexpr int NB_A = 4352 / 32, NB_B = 2304 / 32, NB_C = 1, NB_MEM = 512 / 32, NB_OUT = 2048 / 32;
    constexpr int I_A = KB * NB_A, I_B = KB * NB_B, I_C = KB * NB_C, I_M = KB * NB_MEM, I_O = KB * NB_OUT;
    constexpr int NITEMS = I_A + I_B + I_C + I_M + I_O;
    for (int it = gw; it < NITEMS; it += NGW) {
        int r = it;
        if (r < I_A) { p0_transpose_item(w_in, DM, NPROJ, 0, WinT, 0, npre, scr, r / NB_A, r % NB_A, F.lane, 32); continue; } r -= I_A;
        if (r < I_B) { p0_transpose_item(w_in, DM, NPROJ, C_MQ, WinT, 4352, npre, scr, r / NB_B, r % NB_B, F.lane, 32); continue; } r -= I_B;
        if (r < I_C) { p0_transpose_item(w_in, DM, NPROJ, C_LR, WinT, 6656, npre, scr, r, 0, F.lane, 16); continue; } r -= I_C;
        if (r < I_M) { p0_transpose_item(wmem, DM, 512, 0, WmemT, 0, mnw, scr, r / NB_MEM, r % NB_MEM, F.lane, 32); continue; } r -= I_M;
        p0_transpose_item(wout, D_MIX, DM, 0, WoutT, 0, nullptr, scr, r / NB_OUT, r % NB_OUT, F.lane, 32);
    }
    { const int gt = F.vcu * (NWAVES * 64) + F.tid, NT = F.G * NWAVES * 64; GAS v4u* z = (GAS v4u*)(WinT + (size_t)6688 * DM);
      const int n16 = (6912 - 6688) * DM * 2 / 16;
      for (int i = gt; i < n16; i += NT) z[i] = (v4u){0u, 0u, 0u, 0u}; }
    bf16_t* xb = (bf16_t*)(ws + WS_XB); float* rstdx = (float*)(ws + WS_RSTDX);
    for (int m = gw; m < M; m += NGW) row_to_bf16(a.in[0] + (size_t)m * DM, xb + (size_t)m * DM, rstdx + m, F.lane);
    bf16_t* memb = (bf16_t*)(ws + WS_MEMB); float* rstdm = (float*)(ws + WS_RSTDM);
    for (int m = gw; m < 512; m += NGW) row_to_bf16(a.in[1] + (size_t)m * DM, memb + (size_t)m * DM, rstdm + m, F.lane);
    { const int gt = F.vcu * (NWAVES * 64) + F.tid, NT = F.G * NWAVES * 64; float* T = (float*)(ws + WS_BIAS); const float* rel_bias = a.in[4];
      for (int i = gt; i < 3 * 12 * 132; i += NT) { const int rel = i % 132, h = (i / 132) % 12, p = i / (132 * 12); const int dil = p == 0 ? 1 : (p == 1 ? 4 : 16);
          T[i] = rel <= 128 ? rel_bias[t5_bucket(rel * dil) * 12 + h] : 0.f; } }
}

__device__ __forceinline__ void run_phases(Frame& F, const Args& args, const XcdBarrier& bar, const int lo, const int hi) {
    unsigned char* ws = args.ws;
#define IN(k) (lo <= (k) && (k) < hi)
#define NREP(k) ((k) == REP_PHASE ? 3 : 1)
#define BOTH(k) (IN(k) && IN((k) + 1))
    if (IN(0)) { for (int rep = 0; rep < NREP(0); ++rep) p0_prologue(F, args); if (BOTH(0)) xcd_barrier(bar); }
    if (IN(1)) {
#define GEMM1_BLOCK \
        { pg8::Gemm g{(const pg8::bf16_t*)(ws + WS_XB), (const pg8::bf16_t*)(ws + WS_WIN), M + 512, 6912 + 512, DM}; pg8::ProjOrder S; S.init(F.G, (int)blockIdx.x); \
          pg8::EpiProj E{ws, (const float*)(ws + WS_RSTDX)}; \
          pg8::gemm_phase<pg8::EpiProj, pg8::ProjOrder, PG8_ALIGN, PG8_SP2>(F.lds + RING_OFF, g, S, E); }
        GEMM1_BLOCK
#if REP_PHASE == 1
        GEMM1_BLOCK
        GEMM1_BLOCK
#endif
        if (BOTH(1)) xcd_barrier(bar);
    }
    if (IN(2)) {
        for (int rep = 0; rep < NREP(2); ++rep) for (int u = F.vcu; u < N_DIL_UNITS; u += F.G) dil_attn_unit(F, ws, u);
        for (int rep = 0; rep < NREP(7); ++rep) for (int u = F.vcu; u < N_MEM_UNITS; u += F.G) mem_attn_unit(F, ws, u);
#if STEP >= 2
        for (int rep = 0; rep < NREP(8); ++rep) for (int u = F.vcu; u < N_GLA_UNITS; u += F.G) gla_a_unit(F, ws, args.in[5], args.in[6], u);
#endif
        if (BOTH(2)) xcd_barrier(bar);
    }
    if (IN(3)) {
        for (int rep = 0; rep < NREP(3); ++rep) {
        if (F.tid < 128) { for (int i = F.vcu * 128 + F.tid; i < 8 * 256 * 16; i += F.G * 128) gla_scan_item(ws, i); }
#if STEP >= 3
        else { for (int i = F.vcu * 384 + (F.tid - 128); i < M * 96; i += F.G * 384) dil_combine_item(ws, i); }
#endif
        }
        if (BOTH(3)) xcd_barrier(bar);
    }
    if (IN(4)) {
        for (int rep = 0; rep < NREP(4); ++rep) for (int u = F.vcu; u < N_GLA_UNITS; u += F.G) gla_c_unit(F, ws, args.in[7], u);
        if (BOTH(4)) { xcd_barrier(bar);
#if REP_PHASE == 9
            xcd_barrier(bar); xcd_barrier(bar); xcd_barrier(bar); xcd_barrier(bar);
#endif
        }
    }
    if (IN(5)) {
#define GEMM2_BLOCK { \
        pg8::Gemm g{(const pg8::bf16_t*)(ws + WS_MIXG), (const pg8::bf16_t*)(ws + WS_WOUT), M, DM, D_MIX}; pg8::StaticOrder S; S.init(M, DM, F.G, (int)blockIdx.x); \
        pg8::EpiF32 E{(float*)(ws + WS_Y), DM}; \
        pg8::gemm_phase<pg8::EpiF32, pg8::StaticOrder, PG8_ALIGN, PG8_SP2>(F.lds + RING_OFF, g, S, E); }
        GEMM2_BLOCK
#if REP_PHASE == 5
        GEMM2_BLOCK
        GEMM2_BLOCK
#endif
        if (BOTH(5)) xcd_barrier(bar);
    }
    if (IN(6)) {
        const int gw = F.vcu * NWAVES + F.wave, NGW = F.G * NWAVES;
        for (int rep = 0; rep < NREP(6); ++rep) for (int m = gw; m < M; m += NGW) final_row(args.in[0] + (size_t)m * DM, (const float*)(ws + WS_Y) + (size_t)m * DM, args.in[11], args.out + (size_t)m * DM, F.lane);
    }
#undef IN
#undef BOTH
}

__global__ void __launch_bounds__(NWAVES * 64, 2) fwd(Args args) {
    __shared__ __attribute__((aligned(16))) unsigned char lds_raw[LDS_BYTES];
    Frame F;
    F.lds = (LAS unsigned char*)lds_raw;
    F.MISC = (volatile LAS unsigned*)(F.lds + MISC_OFF);
    F.tid = threadIdx.x; F.lane = F.tid & 63; F.wave = __builtin_amdgcn_readfirstlane(F.tid >> 6);
    F.G = gridDim.x; { const int bx = blockIdx.x; F.vcu = (F.G % 8 == 0) ? (bx % 8) * (F.G / 8) + bx / 8 : bx; }
    unsigned char* ws = args.ws;
    gu32* ctl = (gu32*)(ws + WS_CTL);
    for (int u = F.tid; u < (LDS_BYTES - RING_BYTES) / 4; u += NWAVES * 64) ((LAS unsigned*)(F.lds + RING_BYTES))[u] = 0u;
    __syncthreads();
    const int lo = args.ph_lo, hi = args.ph_hi;
    const bool multi = (hi - lo) > 1 || PREFIX_K > 0;
    XcdBarrier bar; bar.bar = (unsigned*)(ctl + CW_BAR); bar.x = 0; bar.st = nullptr;
    if (multi) bar = xcd_barrier_post((unsigned*)(ctl + CW_BAR), F.MISC + 8);
#if PREFIX_K > 0
    run_phases(F, args, bar, 0, PREFIX_K); xcd_barrier(bar);
#endif
    run_phases(F, args, bar, lo, hi);
}

extern "C" void kernel_launch(void* const* d_in, const int* in_sizes, int n_in, void* d_out, int out_size, void* d_ws, size_t ws_size, hipStream_t stream) {
    static int grid = 0;
    if (grid == 0) {
        int dev = 0, cus = 0;
        if (hipGetDevice(&dev) != hipSuccess || hipDeviceGetAttribute(&cus, hipDeviceAttributeMultiprocessorCount, dev) != hipSuccess) { fprintf(stderr, "kernel_launch: device query failed\n"); grid = -1; return; }
        grid = cus;
    }
    if (grid < 0) return;
    unsigned char* ws = (unsigned char*)d_ws; float* out = (float*)d_out;
    (void)hipMemsetAsync(ws + WS_CTL, 0, CTL_ZERO_BYTES, stream);
    Args a{};
    for (int i = 0; i < 12; ++i) a.in[i] = (const float*)d_in[i];
    a.out = out; a.ws = ws;
#define LAUNCH(lo_, hi_) do { a.ph_lo = (lo_); a.ph_hi = (hi_); hipLaunchKernelGGL(fwd, dim3(grid), dim3(NWAVES * 64), 0, stream, a); } while (0)
#if ONE_LAUNCH
    LAUNCH(0, 7);
#else
    LAUNCH(0, 1); LAUNCH(1, 2); LAUNCH(2, 3); LAUNCH(3, 4); LAUNCH(4, 5); LAUNCH(5, 6); LAUNCH(6, 7);
#endif
}
```
